# Optimizing an MI355X kernel written in HIP

```python
import math
import jax
import jax.numpy as jnp
from jax import lax
import numpy as np

D_MODEL = 1024
BATCH = 8
SEQ = 4096
DEPTH = 1

MOBA_HEADS = 8
MOBA_HEAD_DIM = 64
MOBA_BLOCK = 256
MOBA_TOPK = 3
MOBA_Q_CHUNK = 32
GLA_HEADS = 4
GLA_DK = D_MODEL // 2 // GLA_HEADS
GLA_DV = D_MODEL // GLA_HEADS
GLA_GATE_RANK = 16
GLA_GATE_TAU = 16.0
GLA_CHUNK = 64
T5_BUCKETS = 32
T5_MAX_DIST = 128
D_FF = 4 * D_MODEL
EPS = 1e-6

MOBA_WIDTH = MOBA_HEADS * MOBA_HEAD_DIM
GLA_K_WIDTH = GLA_HEADS * GLA_DK
GLA_V_WIDTH = GLA_HEADS * GLA_DV
IN_SPLIT_SIZES = (MOBA_WIDTH, MOBA_WIDTH, MOBA_WIDTH,
                  GLA_K_WIDTH, GLA_K_WIDTH, GLA_V_WIDTH, GLA_GATE_RANK, GLA_V_WIDTH,
                  D_MODEL, D_MODEL)
IN_SPLIT_POINTS = tuple(sum(IN_SPLIT_SIZES[:i + 1]) for i in range(len(IN_SPLIT_SIZES) - 1))
D_IN = sum(IN_SPLIT_SIZES)

kernel_name = "hybrid_moba_gla_gated_block"


def rms_norm(x, gain):
    xf = x.astype(jnp.float32)
    y = xf * lax.rsqrt(jnp.mean(xf * xf, axis=-1, keepdims=True) + EPS) * gain.astype(jnp.float32)
    return y.astype(x.dtype)


def t5_bucket(dist):
    max_exact = T5_BUCKETS // 2
    d = jnp.maximum(dist, 0)
    large = max_exact + (jnp.log(jnp.maximum(d, 1).astype(jnp.float32) / max_exact)
                         / math.log(T5_MAX_DIST / max_exact)
                         * (T5_BUCKETS - max_exact)).astype(jnp.int32)
    large = jnp.minimum(large, T5_BUCKETS - 1)
    return jnp.where(d < max_exact, d, large)


def moba_attention(q, k, v, t5_bias):
    B, S, H, Dh = q.shape
    q = q.transpose(0, 2, 1, 3)
    k = k.transpose(0, 2, 1, 3)
    v = v.transpose(0, 2, 1, 3)
    nb = -(-S // MOBA_BLOCK)
    s_pad = nb * MOBA_BLOCK
    pad = ((0, 0), (0, 0), (0, s_pad - S), (0, 0))
    kb = jnp.pad(k, pad).reshape(B, H, nb, MOBA_BLOCK, Dh)
    vb = jnp.pad(v, pad).reshape(B, H, nb, MOBA_BLOCK, Dh)
    scale = Dh ** -0.5
    q_block = jnp.arange(S) // MOBA_BLOCK
    n_sel = min(MOBA_TOPK, nb - 1)
    if n_sel > 0:
        k_mean = kb.astype(jnp.float32).mean(axis=3)
        gate = jnp.einsum("bhsd,bhnd->bhsn", q.astype(jnp.float32), k_mean)
        fully_past = jnp.arange(nb)[None, :] < q_block[:, None]
        gate = jnp.where(fully_past, gate, -jnp.inf)
        _, sel_idx = lax.top_k(gate, n_sel)
    else:
        sel_idx = jnp.zeros((B, H, S, 0), jnp.int32)
    n_chunks = S // MOBA_Q_CHUNK
    q_c = q.reshape(B, H, n_chunks, MOBA_Q_CHUNK, Dh).transpose(2, 0, 1, 3, 4)
    idx_c = sel_idx.reshape(B, H, n_chunks, MOBA_Q_CHUNK, n_sel).transpose(2, 0, 1, 3, 4)
    bias_hb = t5_bias.T
    b_ix = jnp.arange(B)[:, None, None, None]
    h_ix = jnp.arange(H)[None, :, None, None]
    h_ix5 = jnp.arange(H)[None, :, None, None, None]
    blk = jnp.arange(MOBA_BLOCK)

    def chunk_fn(args):
        ci, qc, ic = args
        c0 = ci * MOBA_Q_CHUNK
        t = c0 + jnp.arange(MOBA_Q_CHUNK)
        ob = c0 // MOBA_BLOCK
        k_own = lax.dynamic_index_in_dim(kb, ob, axis=2, keepdims=False)
        v_own = lax.dynamic_index_in_dim(vb, ob, axis=2, keepdims=False)
        d_own = t[:, None] - (ob * MOBA_BLOCK + blk)[None, :]
        l_own = jnp.einsum("bhqd,bhkd->bhqk", qc, k_own).astype(jnp.float32) * scale
        l_own = l_own + bias_hb[:, t5_bucket(d_own)].astype(jnp.float32)
        l_own = jnp.where(d_own >= 0, l_own, -jnp.inf)
        k_sel = kb[b_ix, h_ix, ic]
        v_sel = vb[b_ix, h_ix, ic]
        l_sel = jnp.einsum("bhqd,bhqjkd->bhqjk", qc, k_sel).astype(jnp.float32) * scale
        d_sel = t[None, None, :, None, None] - (ic[..., None] * MOBA_BLOCK + blk)
        l_sel = l_sel + bias_hb[h_ix5, t5_bucket(d_sel)].astype(jnp.float32)
        l_sel = jnp.where((ic < ob)[..., None], l_sel, -jnp.inf)
        l_sel = l_sel.reshape(B, H, MOBA_Q_CHUNK, n_sel * MOBA_BLOCK)
        p = jax.nn.softmax(jnp.concatenate([l_sel, l_own], axis=-1), axis=-1)
        p_sel = p[..., :n_sel * MOBA_BLOCK].astype(v.dtype)
        p_own = p[..., n_sel * MOBA_BLOCK:].astype(v.dtype)
        o = (jnp.einsum("bhqj,bhqjd->bhqd", p_sel,
                        v_sel.reshape(B, H, MOBA_Q_CHUNK, n_sel * MOBA_BLOCK, Dh))
             + jnp.einsum("bhqk,bhkd->bhqd", p_own, v_own))
        return o.astype(q.dtype)

    out = lax.map(chunk_fn, (jnp.arange(n_chunks, dtype=jnp.int32), q_c, idx_c))
    return out.transpose(1, 0, 3, 2, 4).reshape(B, S, H * Dh)


def gla_attention(q, k, v, log_a):
    B, S, H, dk = q.shape
    C = GLA_CHUNK
    nc = S // C

    def chunks(t):
        return t.astype(jnp.float32).reshape(B, nc, C, H, -1).transpose(1, 0, 3, 2, 4)

    qc = chunks(q) * dk ** -0.5
    kc = chunks(k)
    vc = chunks(v)
    b = jnp.cumsum(chunks(log_a), axis=3)
    b_last = b[..., -1:, :]
    q_dec = qc * jnp.exp(b)
    k_inv = kc * jnp.exp(-b)
    k_dec = kc * jnp.exp(b_last - b)
    causal = jnp.tril(jnp.ones((C, C), dtype=bool))
    attn = jnp.where(causal, jnp.einsum("nbhcd,nbhed->nbhce", q_dec, k_inv), 0.0)
    o_intra = jnp.einsum("nbhce,nbhev->nbhcv", attn, vc)

    def step(state, xs):
        qd, kd, vv, bl = xs
        o_inter = jnp.einsum("bhcd,bhdv->bhcv", qd, state)
        state = jnp.exp(bl)[:, :, 0, :, None] * state + jnp.einsum("bhcd,bhcv->bhdv", kd, vv)
        return state, o_inter

    state0 = jnp.zeros((B, H, dk, v.shape[-1]), jnp.float32)
    _, o_inter = lax.scan(step, state0, (q_dec, k_dec, vc, b_last))
    o = o_intra + o_inter
    return o.transpose(1, 0, 3, 2, 4).reshape(B, S, H, v.shape[-1])


def setup_inputs(seed: int = 0) -> dict:
    key = jax.random.key(seed)
    ks = jax.random.split(key, 16)

    def nrm(k, shape, scale):
        return jax.random.normal(k, shape, jnp.float32) * scale

    return {
        "x": nrm(ks[0], (BATCH, SEQ, D_MODEL), 1.0),
        "norm1_g": 1.0 + nrm(ks[1], (DEPTH, D_MODEL), 0.05),
        "w_in": nrm(ks[2], (DEPTH, D_MODEL, D_IN), D_MODEL ** -0.5),
        "moba_q_norm_g": 1.0 + nrm(ks[3], (DEPTH, MOBA_HEAD_DIM), 0.05),
        "moba_k_norm_g": 1.0 + nrm(ks[4], (DEPTH, MOBA_HEAD_DIM), 0.05),
        "t5_bias": nrm(ks[5], (T5_BUCKETS, MOBA_HEADS), 0.5),
        "gla_gate_up": nrm(ks[6], (DEPTH, GLA_GATE_RANK, GLA_K_WIDTH), GLA_GATE_RANK ** -0.5),
        "gla_gate_bias": nrm(ks[7], (DEPTH, GLA_K_WIDTH), 0.1),
        "gla_out_norm_g": 1.0 + nrm(ks[8], (DEPTH, GLA_DV), 0.05),
        "w_branch_moba": nrm(ks[9], (DEPTH, MOBA_WIDTH, D_MODEL), MOBA_WIDTH ** -0.5),
        "w_branch_gla": nrm(ks[10], (DEPTH, GLA_V_WIDTH, D_MODEL), GLA_V_WIDTH ** -0.5),
        "w_out": nrm(ks[11], (DEPTH, D_MODEL, D_MODEL), D_MODEL ** -0.5),
        "norm2_g": 1.0 + nrm(ks[12], (DEPTH, D_MODEL), 0.05),
        "w_up": nrm(ks[13], (DEPTH, D_MODEL, D_FF), D_MODEL ** -0.5),
        "w_down": nrm(ks[14], (DEPTH, D_FF, D_MODEL), D_FF ** -0.5),
    }


def reference(x, norm1_g, w_in, moba_q_norm_g, moba_k_norm_g, t5_bias, gla_gate_up,
              gla_gate_bias, gla_out_norm_g, w_branch_moba, w_branch_gla, w_out,
              norm2_g, w_up, w_down):
    B, S, _ = x.shape
    h = x
    for layer in range(DEPTH):
        n = rms_norm(h, norm1_g[layer])
        proj = n @ w_in[layer]
        (mq, mk, mv, gq, gk, gv, g_low, g_out, gate_moba, gate_gla) = jnp.split(
            proj, IN_SPLIT_POINTS, axis=-1)
        mq = rms_norm(mq.reshape(B, S, MOBA_HEADS, MOBA_HEAD_DIM), moba_q_norm_g[layer])
        mk = rms_norm(mk.reshape(B, S, MOBA_HEADS, MOBA_HEAD_DIM), moba_k_norm_g[layer])
        mv = mv.reshape(B, S, MOBA_HEADS, MOBA_HEAD_DIM)
        y_moba = moba_attention(mq, mk, mv, t5_bias)
        log_a = jax.nn.log_sigmoid(
            (g_low @ gla_gate_up[layer] + gla_gate_bias[layer]).astype(jnp.float32)) / GLA_GATE_TAU
        y_gla = gla_attention(gq.reshape(B, S, GLA_HEADS, GLA_DK),
                              gk.reshape(B, S, GLA_HEADS, GLA_DK),
                              gv.reshape(B, S, GLA_HEADS, GLA_DV),
                              log_a.reshape(B, S, GLA_HEADS, GLA_DK))
        y_gla = rms_norm(y_gla, gla_out_norm_g[layer]).astype(x.dtype)
        y_gla = (y_gla * jax.nn.silu(g_out.reshape(B, S, GLA_HEADS, GLA_DV))).reshape(B, S, GLA_V_WIDTH)
        mixed = (jax.nn.sigmoid(gate_moba) * (y_moba @ w_branch_moba[layer])
                 + jax.nn.sigmoid(gate_gla) * (y_gla @ w_branch_gla[layer]))
        h = h + mixed @ w_out[layer]
        n2 = rms_norm(h, norm2_g[layer])
        h = h + jnp.square(jax.nn.relu(n2 @ w_up[layer])) @ w_down[layer]
    return h
```

```cpp
#include <hip/hip_runtime.h>
#include <hip/hip_bf16.h>
#include <cstdio>
#include <cstdint>
#include <cmath>
namespace pg8 {
#define PG8_LAS __attribute__((address_space(3)))
typedef unsigned short bf16_t;
typedef short bf16x8 __attribute__((ext_vector_type(8)));
typedef float f32x4 __attribute__((ext_vector_type(4)));
typedef unsigned u32x4 __attribute__((ext_vector_type(4)));
constexpr int BM = 256, BK = 64, HALF = 128, HTB = HALF * BK * 2  , STAGE_BYTES = 8 * HTB, NXCD = 8, WGM = 8;

__host__ __device__ __forceinline__ int lds_byte(int r, int c) { const int st = (r >> 4) * 2 + (c >> 5), rr = r & 15, cc = c & 31, ob = rr * 64 + cc * 2; return st * 1024 + (ob ^ (((ob >> 9) & 1) << 5)); }
__host__ __device__ __forceinline__ void stage_rc(int b, int& R, int& C) { const int st = b / 1024, sb = b % 1024, swz = sb ^ (((sb >> 9) & 1) << 5); R = (st >> 1) * 16 + swz / 64; C = (st & 1) * 32 + (swz % 64) / 2; }
__host__ __device__ __forceinline__ int perm32(int rho) { const int n = rho >> 4, i = rho & 15; return 8 * (i >> 2) + 4 * n + (i & 3); }

struct Unit { int pm, pn; };
struct Gemm { const bf16_t* A; const bf16_t* Bt; int M, N, K; };

struct StaticOrder {
    int nM, nN, nwg, G, c;
    __host__ __device__ void init(int M, int N, int G_, int c_) { nM = M / BM; nN = N / BM; nwg = nM * nN; G = G_; c = c_; }
    __host__ __device__ bool next(int i, Unit& u) const {
        const long L = (long)i * G + c; if (L >= nwg) return false;
        int wgid = (int)L; { const int q = nwg / NXCD, r = nwg % NXCD, xcd = wgid % NXCD, off = wgid / NXCD; wgid = (xcd < r ? xcd * (q + 1) : r * (q + 1) + (xcd - r) * q) + off; }
        const int nig = WGM * nN, gid = wgid / nig, fm = gid * WGM, gsz = (nM - fm) < WGM ? (nM - fm) : WGM;
        u.pm = fm + ((wgid % nig) % gsz); u.pn = (wgid % nig) / gsz; return true;
    }
    __device__ __forceinline__ void a_ready(const Unit&) const {}
    __device__ __forceinline__ void done(const Unit&) const {}
};
__device__ __forceinline__ unsigned cvt_pk_bf16(float lo, float hi) { unsigned r; asm volatile("v_cvt_pk_bf16_f32 %0, %1, %2" : "=v"(r) : "v"(lo), "v"(hi)); return r; }
typedef float f32x2 __attribute__((ext_vector_type(2)));
constexpr float RMS_EPS = 1e-6f;
constexpr float QC2 = 0.125f * 1.4426950408889634f;
__device__ __forceinline__ float bflo(unsigned w) { return __uint_as_float(w << 16); }
__device__ __forceinline__ float bfhi(unsigned w) { return __uint_as_float(w & 0xffff0000u); }
__device__ __forceinline__ float sigm(float v) { return __builtin_amdgcn_rcpf(1.0f + __expf(-v)); }
__device__ __forceinline__ u32x4 pack8(const f32x4& v0, const f32x4& v1) { u32x4 w; w.x = cvt_pk_bf16(v0[0], v0[1]); w.y = cvt_pk_bf16(v0[2], v0[3]); w.z = cvt_pk_bf16(v1[0], v1[1]); w.w = cvt_pk_bf16(v1[2], v1[3]); return w; }

struct EpiProj {
    static constexpr bool PERM = true, AFTER_DRAIN = false;
    bf16_t *Q, *Kb, *V, *GV, *SA; float* kmean; const float *qg, *kg;
    __device__ __forceinline__ void operator()(const f32x4 (&acc)[2][2][4][2], const Unit& u, int wr, int wc, int fr, int fq) const {
        const int pn = u.pn; const int row0 = u.pm * BM + wr * 64 + fr;
        if (pn < 4) {
            const bool isk = pn >= 2; const int head = (pn & 1) * 4 + wc;
            const float* gp = (isk ? kg : qg) + 8 * fq; const float sc = isk ? 1.0f : QC2;
            f32x4 g[2][2];
#pragma unroll
            for (int bj = 0; bj < 2; ++bj)
#pragma unroll
                for (int n = 0; n < 2; ++n) g[bj][n] = *(const f32x4*)(gp + bj * 32 + 4 * n) * sc;
            bf16_t* base = (isk ? Kb : Q) + head * 64 + 8 * fq;
            f32x4 cs[2][2];
#pragma unroll
            for (int bj = 0; bj < 2; ++bj)
#pragma unroll
                for (int n = 0; n < 2; ++n) cs[bj][n] = (f32x4){0.f, 0.f, 0.f, 0.f};
#pragma unroll
            for (int ai = 0; ai < 2; ++ai)
#pragma unroll
                for (int m = 0; m < 4; ++m) {
                    float ss = 0.f;
#pragma unroll
                    for (int bj = 0; bj < 2; ++bj)
#pragma unroll
                        for (int n = 0; n < 2; ++n) { const f32x4 x = acc[ai][bj][m][n]; ss += (x[0] * x[0] + x[1] * x[1]) + (x[2] * x[2] + x[3] * x[3]); }
                    ss += __shfl_xor(ss, 16); ss += __shfl_xor(ss, 32);
                    const float rstd = rsqrtf(ss * (1.0f / 64.0f) + RMS_EPS);
                    bf16_t* rowp = base + (size_t)(row0 + ai * HALF + m * 16) * 512;
#pragma unroll
                    for (int bj = 0; bj < 2; ++bj) { const f32x4 v0 = acc[ai][bj][m][0] * rstd * g[bj][0], v1 = acc[ai][bj][m][1] * rstd * g[bj][1];
                        cs[bj][0] += v0; cs[bj][1] += v1; *(u32x4*)(rowp + bj * 32) = pack8(v0, v1); }
                }
            if (isk) {
                float* km = kmean + ((size_t)u.pm * 8 + head) * 64 + 8 * fq;
#pragma unroll
                for (int bj = 0; bj < 2; ++bj)
#pragma unroll
                    for (int n = 0; n < 2; ++n)
#pragma unroll
                        for (int e = 0; e < 4; ++e) { float v = cs[bj][n][e]; v += __shfl_xor(v, 1); v += __shfl_xor(v, 2); v += __shfl_xor(v, 4); v += __shfl_xor(v, 8);
                            if (fr == 0) atomicAdd(km + bj * 32 + 4 * n + e, v * (1.0f / 256.0f)); }
            }
        } else {
            bf16_t* base; int pitch, t, act;
            if (pn < 10) { const int grp = (pn - 4) >> 1; base = V + (size_t)grp * (16u << 20); pitch = 512; t = (pn - 4) & 1; act = 0; }
            else if (pn < 18) { const int grp = (pn - 10) >> 2; base = GV + (size_t)grp * (32u << 20); pitch = 1024; t = (pn - 10) & 3; act = grp; }
            else { const int grp = (pn - 18) >> 2; base = SA + (size_t)grp * ((size_t)32768 * 1024); pitch = 1024; t = (pn - 18) & 3; act = 2; }
            const int col0 = t * BM + wc * 32 + 8 * fq;
#pragma unroll
            for (int ai = 0; ai < 2; ++ai)
#pragma unroll
                for (int m = 0; m < 4; ++m) { bf16_t* rowp = base + (size_t)(row0 + ai * HALF + m * 16) * pitch + col0;
#pragma unroll
                    for (int bj = 0; bj < 2; ++bj) { f32x4 v0 = acc[ai][bj][m][0], v1 = acc[ai][bj][m][1];
                        if (act != 0) {
#pragma unroll
                            for (int e = 0; e < 4; ++e) { const float s0 = sigm(v0[e]), s1 = sigm(v1[e]); v0[e] = (act == 1) ? v0[e] * s0 : s0; v1[e] = (act == 1) ? v1[e] * s1 : s1; } }
                        *(u32x4*)(rowp + bj * HALF) = pack8(v0, v1); } }
        }
    }
};
template <bool ADD> struct EpiMix {
    static constexpr bool PERM = true, AFTER_DRAIN = false;
    const bf16_t* S; bf16_t* MIX;
    __device__ __forceinline__ void operator()(const f32x4 (&acc)[2][2][4][2], const Unit& u, int wr, int wc, int fr, int fq) const {
        const int row0 = u.pm * BM + wr * 64 + fr, col0 = u.pn * BM + wc * 32 + 8 * fq;
#pragma unroll
        for (int ai = 0; ai < 2; ++ai)
#pragma unroll
            for (int m = 0; m < 4; ++m) { const size_t off = (size_t)(row0 + ai * HALF + m * 16) * 1024 + col0;
#pragma unroll
                for (int bj = 0; bj < 2; ++bj) { const u32x4 s = *(const u32x4*)(S + off + bj * HALF);
                    f32x4 v0 = acc[ai][bj][m][0] * (f32x4){bflo(s.x), bfhi(s.x), bflo(s.y), bfhi(s.y)}, v1 = acc[ai][bj][m][1] * (f32x4){bflo(s.z), bfhi(s.z), bflo(s.w), bfhi(s.w)};
                    if (ADD) { const u32x4 p = *(const u32x4*)(MIX + off + bj * HALF); v0 += (f32x4){bflo(p.x), bfhi(p.x), bflo(p.y), bfhi(p.y)}; v1 += (f32x4){bflo(p.z), bfhi(p.z), bflo(p.w), bfhi(p.w)}; }
                    *(u32x4*)(MIX + off + bj * HALF) = pack8(v0, v1); } }
    }
};
struct EpiWout {
    static constexpr bool PERM = true, AFTER_DRAIN = false;
    const float* x; float* out; bf16_t* H1B; float* ssq;
    __device__ __forceinline__ void operator()(const f32x4 (&acc)[2][2][4][2], const Unit& u, int wr, int wc, int fr, int fq) const {
        const int row0 = u.pm * BM + wr * 64 + fr, col0 = u.pn * BM + wc * 32 + 8 * fq;
#pragma unroll
        for (int ai = 0; ai < 2; ++ai)
#pragma unroll
            for (int m = 0; m < 4; ++m) { const int row = row0 + ai * HALF + m * 16; const size_t off = (size_t)row * 1024 + col0; float ss = 0.f;
#pragma unroll
                for (int bj = 0; bj < 2; ++bj) { const f32x4 h0 = *(const f32x4*)(x + off + bj * HALF) + acc[ai][bj][m][0], h1 = *(const f32x4*)(x + off + bj * HALF + 4) + acc[ai][bj][m][1];
                    *(f32x4*)(out + off + bj * HALF) = h0; *(f32x4*)(out + off + bj * HALF + 4) = h1; *(u32x4*)(H1B + off + bj * HALF) = pack8(h0, h1);
                    ss += (h0[0] * h0[0] + h0[1] * h0[1]) + (h0[2] * h0[2] + h0[3] * h0[3]) + (h1[0] * h1[0] + h1[1] * h1[1]) + (h1[2] * h1[2] + h1[3] * h1[3]); }
                ss += __shfl_xor(ss, 16); ss += __shfl_xor(ss, 32);
                if (fq == 0) ssq[(size_t)row * 16 + u.pn * 4 + wc] = ss; }
    }
};
struct EpiUp {
    static constexpr bool PERM = true, AFTER_DRAIN = false;
    const float* ssq; bf16_t* HB;
    __device__ __forceinline__ void operator()(const f32x4 (&acc)[2][2][4][2], const Unit& u, int wr, int wc, int fr, int fq) const {
        const int row0 = u.pm * BM + wr * 64 + fr, col0 = u.pn * BM + wc * 32 + 8 * fq;
#pragma unroll
        for (int ai = 0; ai < 2; ++ai)
#pragma unroll
            for (int m = 0; m < 4; ++m) { const int row = row0 + ai * HALF + m * 16; const f32x4* sp = (const f32x4*)(ssq + (size_t)row * 16);
                const f32x4 a = sp[0], b = sp[1], c = sp[2], d = sp[3]; const f32x4 t = (a + b) + (c + d);
                const float rstd = rsqrtf(((t[0] + t[1]) + (t[2] + t[3])) * (1.0f / 1024.0f) + RMS_EPS);
                bf16_t* rowp = HB + (size_t)row * 4096 + col0;
#pragma unroll
                for (int bj = 0; bj < 2; ++bj) { f32x4 v0 = acc[ai][bj][m][0] * rstd, v1 = acc[ai][bj][m][1] * rstd;
#pragma unroll
                    for (int e = 0; e < 4; ++e) { const float r0 = fmaxf(v0[e], 0.f), r1 = fmaxf(v1[e], 0.f); v0[e] = r0 * r0; v1[e] = r1 * r1; }
                    *(u32x4*)(rowp + bj * HALF) = pack8(v0, v1); } }
    }
};
struct EpiDown {
    static constexpr bool PERM = false, AFTER_DRAIN = false;
    float* out;
    __device__ __forceinline__ void operator()(const f32x4 (&acc)[2][2][4][2], const Unit& u, int wr, int wc, int fr, int fq) const {
        const int row0 = u.pm * BM + wr * 64 + fr, col0 = u.pn * BM + wc * 32 + 4 * fq;
#pragma unroll
        for (int ai = 0; ai < 2; ++ai)
#pragma unroll
            for (int m = 0; m < 4; ++m) { float* rowp = out + (size_t)(row0 + ai * HALF + m * 16) * 1024 + col0;
#pragma unroll
                for (int bj = 0; bj < 2; ++bj)
#pragma unroll
                    for (int n = 0; n < 2; ++n) { f32x4* p = (f32x4*)(rowp + bj * HALF + n * 16); *p = *p + acc[ai][bj][m][n]; } }
    }
};

template <class Epi, class Sched, bool ALIGN_EPI = false, bool SP2 = false>
__device__ __forceinline__ void gemm_phase(PG8_LAS unsigned char* lds, const Gemm g, const Sched& S, const Epi& E) {
    const int tid = threadIdx.x, wid = __builtin_amdgcn_readfirstlane(tid >> 6), lane = tid & 63, wr = wid >> 2, wc = wid & 3, fr = lane & 15, fq = lane >> 4;
    const int K = g.K, nt = K / BK;
    unsigned voffA[2], voffB[2];
#pragma unroll
    for (int i = 0; i < 2; ++i) { int R, C; stage_rc(tid * 16 + i * 8192, R, C); const int Rb = Epi::PERM ? ((R & ~31) + perm32(R & 31)) : R;
        voffA[i] = (unsigned)(R * K + C) * 2u; voffB[i] = (unsigned)(Rb * K + C) * 2u; }
    const size_t kstep = (size_t)(BK * 2);
    const size_t hstep = (size_t)HALF * K * 2;
    const size_t tstep = 2 * hstep;
    const unsigned ldsw = (unsigned)wid * 1024u;
    const int aoff = lds_byte(wr * 64 + fr, fq * 8), boff = lds_byte(wc * 32 + fr, fq * 8);
#define PG8_SA(b, h) (((b) * 2 + (h)) * HTB)
#define PG8_SB(b, h) ((4 + (b) * 2 + (h)) * HTB)
#define PG8_STAGE(bufoff, gbase, voff) do { _Pragma("unroll") for (int _i = 0; _i < 2; ++_i) \
        __builtin_amdgcn_global_load_lds((const unsigned*)((const char*)(gbase) + (voff)[_i]), (PG8_LAS unsigned*)(lds + (bufoff) + ldsw + _i * 8192), 16, 0, 0); } while (0)
#define PG8_LDA(dst, b, h) do { _Pragma("unroll") for (int m = 0; m < 4; ++m) _Pragma("unroll") for (int k = 0; k < 2; ++k) dst[m][k] = *(const PG8_LAS bf16x8*)(lds + PG8_SA(b, h) + aoff + m * 2048 + k * 1024); } while (0)
#define PG8_LDB(dst, b, h) do { _Pragma("unroll") for (int n = 0; n < 2; ++n) _Pragma("unroll") for (int k = 0; k < 2; ++k) dst[n][k] = *(const PG8_LAS bf16x8*)(lds + PG8_SB(b, h) + boff + n * 2048 + k * 1024); } while (0)
#define PG8_MMA(ai, bj, At, Bt) do { __builtin_amdgcn_s_setprio(1); _Pragma("unroll") for (int m = 0; m < 4; ++m) _Pragma("unroll") for (int n = 0; n < 2; ++n) _Pragma("unroll") for (int k = 0; k < 2; ++k) \
        acc[ai][bj][m][n] = __builtin_amdgcn_mfma_f32_16x16x32_bf16(Bt[n][k], At[m][k], acc[ai][bj][m][n], 0, 0, 0); __builtin_amdgcn_s_setprio(0); } while (0)
#define PG8_WAIT_V(n) asm volatile("s_waitcnt vmcnt(" #n ")" ::: "memory")
#define PG8_WAIT_L(n) asm volatile("s_waitcnt lgkmcnt(" #n ")" ::: "memory")
#define PG8_BAR __builtin_amdgcn_s_barrier()
#define PG8_SCHED __builtin_amdgcn_sched_barrier(0)
    Unit cur, nxt; int ui = 0;
    if (!S.next(0, cur)) return;
    f32x4 acc[2][2][4][2];
#pragma unroll
    for (int a = 0; a < 2; ++a)
#pragma unroll
        for (int b = 0; b < 2; ++b)
#pragma unroll
            for (int m = 0; m < 4; ++m)
#pragma unroll
                for (int n = 0; n < 2; ++n) acc[a][b][m][n] = (f32x4){0.f, 0.f, 0.f, 0.f};
    bf16x8 At[4][2], B0[2][2], B1[2][2];
    const char* cA = (const char*)g.A + (size_t)cur.pm * tstep; const char* cB = (const char*)g.Bt + (size_t)cur.pn * tstep;
    S.a_ready(cur);
    if constexpr (SP2) {
        PG8_STAGE(PG8_SB(0, 0), cB, voffB); PG8_STAGE(PG8_SB(0, 1), cB + hstep, voffB); PG8_STAGE(PG8_SA(0, 0), cA, voffA); PG8_STAGE(PG8_SA(0, 1), cA + hstep, voffA);
        if (wr == 1) PG8_BAR;
        PG8_WAIT_V(2); PG8_BAR;
        PG8_STAGE(PG8_SB(1, 0), cB + kstep, voffB); PG8_STAGE(PG8_SA(1, 0), cA + kstep, voffA); PG8_STAGE(PG8_SB(1, 1), cB + hstep + kstep, voffB);
        PG8_WAIT_V(6); PG8_BAR;
    } else {
        PG8_STAGE(PG8_SB(0, 0), cB, voffB); PG8_STAGE(PG8_SA(0, 0), cA, voffA); PG8_STAGE(PG8_SB(0, 1), cB + hstep, voffB); PG8_STAGE(PG8_SA(0, 1), cA + hstep, voffA);
        if (wr == 1) PG8_BAR;
        PG8_WAIT_V(4); PG8_BAR;
        PG8_STAGE(PG8_SB(1, 0), cB + kstep, voffB); PG8_STAGE(PG8_SA(1, 0), cA + kstep, voffA); PG8_STAGE(PG8_SB(1, 1), cB + hstep + kstep, voffB);
        PG8_WAIT_V(6); PG8_BAR;
    }
    for (;;) {
        const bool has_next = S.next(ui + 1, nxt);
        const char* nA = has_next ? (const char*)g.A + (size_t)nxt.pm * tstep : cA; const char* nB = has_next ? (const char*)g.Bt + (size_t)nxt.pn * tstep : cB;
        for (int t = 0; t < nt; t += 2) {
            const bool last = (t == nt - 2);
            const char* a1 = cA + (size_t)(t + 1) * kstep;
            const char* a2 = last ? nA : cA + (size_t)(t + 2) * kstep; const char* b2 = last ? nB : cB + (size_t)(t + 2) * kstep;
            const char* a3 = a2 + kstep; const char* b3 = b2 + kstep;
            if (last && has_next) S.a_ready(nxt);
            if constexpr (SP2) {
            PG8_LDB(B0, 0, 0); PG8_LDB(B1, 0, 1); PG8_SCHED; PG8_LDA(At, 0, 0); PG8_STAGE(PG8_SA(1, 1), a1 + hstep, voffA);
            PG8_WAIT_V(8); PG8_WAIT_L(0); PG8_BAR; PG8_MMA(0, 0, At, B0); PG8_MMA(0, 1, At, B1); PG8_BAR; PG8_SCHED;
            PG8_LDA(At, 0, 1); PG8_STAGE(PG8_SB(0, 0), b2, voffB); PG8_STAGE(PG8_SB(0, 1), b2 + hstep, voffB); PG8_STAGE(PG8_SA(0, 0), a2, voffA);
            PG8_WAIT_V(8); PG8_WAIT_L(0); PG8_BAR; PG8_MMA(1, 0, At, B0); PG8_MMA(1, 1, At, B1); PG8_BAR; PG8_SCHED;
            PG8_LDB(B0, 1, 0); PG8_LDB(B1, 1, 1); PG8_SCHED; PG8_LDA(At, 1, 0); PG8_STAGE(PG8_SA(0, 1), a2 + hstep, voffA);
            PG8_WAIT_V(8); PG8_WAIT_L(0); PG8_BAR; PG8_MMA(0, 0, At, B0); PG8_MMA(0, 1, At, B1); PG8_BAR; PG8_SCHED;
            PG8_LDA(At, 1, 1); PG8_STAGE(PG8_SB(1, 0), b3, voffB); PG8_STAGE(PG8_SB(1, 1), b3 + hstep, voffB); PG8_STAGE(PG8_SA(1, 0), a3, voffA);
            PG8_WAIT_V(8); PG8_WAIT_L(0); PG8_BAR; PG8_MMA(1, 0, At, B0); PG8_MMA(1, 1, At, B1); PG8_BAR; PG8_SCHED;
            } else {
            PG8_LDB(B0, 0, 0); PG8_SCHED; PG8_LDA(At, 0, 0); PG8_STAGE(PG8_SA(1, 1), a1 + hstep, voffA);
            PG8_WAIT_L(8); PG8_BAR; PG8_WAIT_L(0); PG8_MMA(0, 0, At, B0); PG8_BAR; PG8_SCHED;
            PG8_LDB(B1, 0, 1); PG8_STAGE(PG8_SB(0, 0), b2, voffB);
            PG8_BAR; PG8_WAIT_L(0); PG8_MMA(0, 1, At, B1); PG8_BAR;
            PG8_LDA(At, 0, 1); PG8_STAGE(PG8_SA(0, 0), a2, voffA);
            PG8_BAR; PG8_WAIT_L(0); PG8_MMA(1, 0, At, B0); PG8_BAR; PG8_SCHED;
            PG8_STAGE(PG8_SB(0, 1), b2 + hstep, voffB);
            PG8_WAIT_V(6); PG8_BAR; PG8_MMA(1, 1, At, B1); PG8_BAR;
            PG8_LDB(B0, 1, 0); PG8_SCHED; PG8_LDA(At, 1, 0); PG8_STAGE(PG8_SA(0, 1), a2 + hstep, voffA);
            PG8_WAIT_L(8); PG8_BAR; PG8_WAIT_L(0); PG8_MMA(0, 0, At, B0); PG8_BAR; PG8_SCHED;
            PG8_LDB(B1, 1, 1); PG8_STAGE(PG8_SB(1, 0), b3, voffB);
            PG8_BAR; PG8_WAIT_L(0); PG8_MMA(0, 1, At, B1); PG8_BAR;
            PG8_LDA(At, 1, 1); PG8_STAGE(PG8_SA(1, 0), a3, voffA);
            PG8_BAR; PG8_WAIT_L(0); PG8_MMA(1, 0, At, B0); PG8_BAR; PG8_SCHED;
            PG8_STAGE(PG8_SB(1, 1), b3 + hstep, voffB);
            PG8_WAIT_V(6); PG8_BAR; PG8_MMA(1, 1, At, B1); PG8_BAR;
            }
        }
        if constexpr (ALIGN_EPI) { if (wr == 0) PG8_BAR; }
        if constexpr (!Epi::AFTER_DRAIN) { E(acc, cur, wr, wc, fr, fq); S.done(cur); }
        if (!has_next) break;
#pragma unroll
        for (int a = 0; a < 2; ++a)
#pragma unroll
            for (int b = 0; b < 2; ++b)
#pragma unroll
                for (int m = 0; m < 4; ++m)
#pragma unroll
                    for (int n = 0; n < 2; ++n) acc[a][b][m][n] = (f32x4){0.f, 0.f, 0.f, 0.f};
        cur = nxt; cA = nA; cB = nB; ++ui;
        if constexpr (ALIGN_EPI) { if (wr == 1) PG8_BAR; }
    }
    PG8_WAIT_V(0);
    if constexpr (!ALIGN_EPI) { if (wr == 0) PG8_BAR; }
    PG8_BAR;
    if constexpr (Epi::AFTER_DRAIN) { E.fused(acc, cur, wr, wc, fr, fq, lds, wid, lane); S.done(cur); }
#undef PG8_SA
#undef PG8_SB
#undef PG8_STAGE
#undef PG8_LDA
#undef PG8_LDB
#undef PG8_MMA
#undef PG8_WAIT_V
#undef PG8_WAIT_L
#undef PG8_BAR
#undef PG8_SCHED
}
}
constexpr int NWAVES = 8;
constexpr int BATCH = 8, SEQ = 4096, DMODEL = 1024, FF = 4096, M = BATCH * SEQ;
constexpr int D_IN = 6672, NPROJ = 6656;
constexpr int GLOW_COL = 3584;
#ifndef MK_N_LAUNCHES
#define MK_N_LAUNCHES 1
#endif
constexpr int N_PHASES = 8;
constexpr int N_LAUNCHES = MK_N_LAUNCHES;

constexpr size_t MiB = 1u << 20;
constexpr size_t WS_CTL = 0, WS_KMEAN = 1 * MiB, CTL_ZERO_BYTES = 2 * MiB;
constexpr size_t WS_SSQ = 2 * MiB, WS_GLOW = 4 * MiB;
constexpr size_t WS_WIN = 6 * MiB, WS_WGL = 19 * MiB, WS_WBA = 20 * MiB, WS_WBG = 21 * MiB, WS_WOUT = 23 * MiB, WS_WUP = 25 * MiB, WS_WDN = 33 * MiB;
constexpr size_t WS_ST = 44 * MiB, WS_XN = 44 * MiB, WS_MIX = 44 * MiB;
constexpr size_t WS_Q = 172 * MiB, WS_K = 204 * MiB, WS_V = 236 * MiB, WS_GQ = 268 * MiB, WS_GK = 300 * MiB;
constexpr size_t WS_GV = 332 * MiB, WS_H1B = 332 * MiB;
constexpr size_t WS_GO = 396 * MiB;
constexpr size_t WS_HB = 44 * MiB;
constexpr size_t WS_END = 460 * MiB;
constexpr int CW_TMO = 0, CW_CODE = 1, CW_BAR = 4096;

constexpr int RING_OFF = 0, RING_BYTES = 131072;
constexpr int LDSCTL_OFF = RING_BYTES, MISC_OFF = LDSCTL_OFF + 320;
constexpr int LDS_BYTES = 147456;
#define GAS __attribute__((address_space(1)))
#define LAS __attribute__((address_space(3)))
typedef unsigned short bf16;
typedef unsigned v4u __attribute__((ext_vector_type(4)));
typedef float f32x4 __attribute__((ext_vector_type(4)));
typedef short bf16x8 __attribute__((ext_vector_type(8)));
typedef GAS unsigned gu32;
typedef GAS unsigned long long gu64;
#define RLX_AGENT __ATOMIC_RELAXED, __HIP_MEMORY_SCOPE_AGENT
#define LDS_WAIT() asm volatile("s_waitcnt lgkmcnt(0)" ::: "memory")
#define VM_WAIT() asm volatile("s_waitcnt vmcnt(0)" ::: "memory")
__device__ __forceinline__ unsigned long long rt() { return __builtin_amdgcn_s_memrealtime(); }
__device__ __forceinline__ unsigned f2bf(float f) { unsigned u = __builtin_bit_cast(unsigned, f); return (u + 0x7fffu + ((u >> 16) & 1u)) >> 16; }
__device__ __forceinline__ unsigned pk2(float lo, float hi) { return f2bf(lo) | (f2bf(hi) << 16); }
#define XB_TMO      128
#define XB_XCNT(j)  (256  + 64 * (j))
#define XB_XSUB(j)  (1280 + 64 * (j))
#define XB_XGEN(j)  (2304 + 64 * (j))
#define XB_TOP      3328
#define XB_TOPGEN   3392
#define XCD_BAR_WORDS 3456
#define XB_SPIN_CAP (1u << 18)

__device__ __forceinline__ unsigned xb_ld(unsigned* p)              { return __hip_atomic_load(p, __ATOMIC_RELAXED, __HIP_MEMORY_SCOPE_AGENT); }
__device__ __forceinline__ unsigned xb_add(unsigned* p, unsigned v) { return __hip_atomic_fetch_add(p, v, __ATOMIC_RELAXED, __HIP_MEMORY_SCOPE_AGENT); }
__device__ __forceinline__ unsigned xb_xcc_id() { return (unsigned)__builtin_amdgcn_s_getreg((3 << 11) | 20) & 0xFu; }
#define XB_SPIN(cond, bar) do { unsigned _sp = 0; while (cond) { __builtin_amdgcn_s_sleep(1); \
    if ((++_sp & 255u) == 0u) { if (xb_ld(&(bar)[XB_TMO])) break; if (_sp > XB_SPIN_CAP) { atomicAdd(&(bar)[XB_TMO], 1u); break; } } } } while (0)

struct XcdBarrier {
    unsigned* bar; unsigned x;
    volatile LAS unsigned* st;
};

__device__ __forceinline__ XcdBarrier xcd_barrier_post(unsigned* bar, volatile LAS unsigned* st) {
    XcdBarrier b; b.bar = bar; b.x = xb_xcc_id(); b.st = st;
    if (threadIdx.x == 0) (void)xb_add(&bar[XB_XCNT(b.x)], 1u);
    return b;
}
__device__ __forceinline__ void xcd_barrier_complete(unsigned* bar, unsigned x, unsigned& nloc, unsigned& nx) {
    const unsigned G = gridDim.x * gridDim.y * gridDim.z;
    unsigned sum, cnt, mine, sp = 0u;
    for (;;) {
        sum = 0u; cnt = 0u; mine = 0u;
#pragma unroll
        for (unsigned j = 0; j < 16; ++j) { const unsigned c = xb_ld(&bar[XB_XCNT(j)]); sum += c; cnt += (c > 0u) ? 1u : 0u; mine = (j == x) ? c : mine; }
        if (sum == G) break;
        __builtin_amdgcn_s_sleep(1);
        if ((++sp & 255u) == 0u) { if (xb_ld(&bar[XB_TMO])) break; if (sp > XB_SPIN_CAP) { atomicAdd(&bar[XB_TMO], 1u); break; } }
    }
    nloc = mine > 0u ? mine : 1u; nx = cnt > 0u ? cnt : 1u;
}

__device__ __forceinline__ void xcd_barrier(const XcdBarrier& b) {
    asm volatile("s_waitcnt vmcnt(0)" ::: "memory");
    __syncthreads();
    if (threadIdx.x == 0) {
        unsigned* bar = b.bar;
        __builtin_amdgcn_s_waitcnt(0);
        unsigned nloc = b.st[0], nx = b.st[1];
        if (nloc == 0u) { xcd_barrier_complete(bar, b.x, nloc, nx); b.st[0] = nloc; b.st[1] = nx; }
        const unsigned old = xb_add(&bar[XB_XSUB(b.x)], 1u);
        const unsigned gen = old / nloc;
        if (old + 1u == (gen + 1u) * nloc) {
            __builtin_amdgcn_fence(__ATOMIC_RELEASE, "agent");
            asm volatile("s_waitcnt vmcnt(0)" ::: "memory");
            const unsigned og = xb_add(&bar[XB_TOP], 1u);
            const unsigned tg = og / nx;
            if (og + 1u == (tg + 1u) * nx) xb_add(&bar[XB_TOPGEN], 1u);
            else XB_SPIN(xb_ld(&bar[XB_TOPGEN]) == tg, bar);
            __builtin_amdgcn_fence(__ATOMIC_ACQUIRE, "agent");
            xb_add(&bar[XB_XGEN(b.x)], 1u);
            asm volatile("s_waitcnt vmcnt(0)" ::: "memory");
        } else {
            XB_SPIN(xb_ld(&bar[XB_XGEN(b.x)]) == gen, bar);
            __builtin_amdgcn_fence(__ATOMIC_ACQUIRE, "agent");
            asm volatile("s_waitcnt vmcnt(0)" ::: "memory");
        }
    }
    __syncthreads();
}
struct Frame {
    LAS unsigned char* lds;
    volatile LAS unsigned* MISC;
    gu32* ctl;
    int tid, lane, wave;
    int vcu, G;
};
__device__ __forceinline__ float wave_sum(float v) {
#pragma unroll
    for (int o = 1; o < 64; o <<= 1) v += __shfl_xor(v, o);
    return v;
}
__device__ __forceinline__ void p0_item(const float* W, int ldw, int scol, int k0, bf16* WT, int K, int drow, const float* ks, LAS float* scr, int lane) {
#pragma unroll 8
    for (int i = 0; i < 32; ++i) { const int kk = 2 * i + (lane >> 5); float v = W[(size_t)(k0 + kk) * ldw + scol + (lane & 31)]; if (ks) v *= ks[k0 + kk]; scr[kk * 33 + (lane & 31)] = v; }
    LDS_WAIT(); asm volatile("" ::: "memory");
    const int c = lane & 7;
#pragma unroll
    for (int j = 0; j < 4; ++j) { const int n = (lane >> 3) + 8 * j; const LAS float* s = scr + (8 * c) * 33 + n;
        v4u o; o.x = pk2(s[0 * 33], s[1 * 33]); o.y = pk2(s[2 * 33], s[3 * 33]); o.z = pk2(s[4 * 33], s[5 * 33]); o.w = pk2(s[6 * 33], s[7 * 33]);
        *(GAS v4u*)(WT + (size_t)(drow + n) * K + k0 + 8 * c) = o; }
    LDS_WAIT(); asm volatile("" ::: "memory");
}
__device__ __forceinline__ int win_src_col(int n0) {
    const int tile = n0 >> 8, pt = n0 & 255;
    int lc = (tile < 4) ? (64 * ((pt >> 5) & 3) + 32 * (pt >> 7)) : pt;
    lc += 256 * tile; return lc >= GLOW_COL ? lc + 16 : lc;
}
struct Ptrs {
    const float *x, *g1, *w_in, *qg, *kg, *t5, *gup, *gbias, *gnorm, *wba, *wbg, *wout, *g2, *wup, *wdn;
    float* out; unsigned char* ws;
};
__device__ __forceinline__ void p0_prologue(Frame& F, const Ptrs& P) {
    LAS float* scr = (LAS float*)(F.lds + RING_OFF + F.wave * 16384);
    const int gw = F.vcu * NWAVES + F.wave, NGW = F.G * NWAVES;
    bf16* WIN = (bf16*)(P.ws + WS_WIN); bf16* WGL = (bf16*)(P.ws + WS_WGL); bf16* WBA = (bf16*)(P.ws + WS_WBA); bf16* WBG = (bf16*)(P.ws + WS_WBG);
    bf16* WOUT = (bf16*)(P.ws + WS_WOUT); bf16* WUP = (bf16*)(P.ws + WS_WUP); bf16* WDN = (bf16*)(P.ws + WS_WDN); bf16* XN = (bf16*)(P.ws + WS_XN);
    constexpr int I_IN = 16 * (NPROJ / 32), I_BA = 8 * 32, I_BG = 16 * 32, I_OUT = 16 * 32, I_UP = 16 * 128, I_DN = 64 * 32;
    constexpr int NITEMS = I_IN + I_BA + I_BG + I_OUT + I_UP + I_DN;
    for (int it = gw; it < NITEMS; it += NGW) {
        int r = it;
        if (r < I_IN) { const int nb = r % (NPROJ / 32), kb = r / (NPROJ / 32); p0_item(P.w_in, D_IN, win_src_col(32 * nb), 64 * kb, WIN, 1024, 32 * nb, nullptr, scr, F.lane); continue; } r -= I_IN;
        if (r < I_BA) { const int nb = r % 32, kb = r / 32; p0_item(P.wba, 1024, 32 * nb, 64 * kb, WBA, 512, 32 * nb, nullptr, scr, F.lane); continue; } r -= I_BA;
        if (r < I_BG) { const int nb = r % 32, kb = r / 32; p0_item(P.wbg, 1024, 32 * nb, 64 * kb, WBG, 1024, 32 * nb, nullptr, scr, F.lane); continue; } r -= I_BG;
        if (r < I_OUT) { const int nb = r % 32, kb = r / 32; p0_item(P.wout, 1024, 32 * nb, 64 * kb, WOUT, 1024, 32 * nb, nullptr, scr, F.lane); continue; } r -= I_OUT;
        if (r < I_UP) { const int nb = r % 128, kb = r / 128; p0_item(P.wup, 4096, 32 * nb, 64 * kb, WUP, 1024, 32 * nb, P.g2, scr, F.lane); continue; } r -= I_UP;
        { const int nb = r % 32, kb = r / 32; p0_item(P.wdn, 1024, 32 * nb, 64 * kb, WDN, 4096, 32 * nb, nullptr, scr, F.lane); }
    }
    for (int idx = gw * 64 + F.lane; idx < 16 * 1024; idx += NGW * 64) { const int j = idx & 15, k = idx >> 4; WGL[j * 1024 + k] = (bf16)f2bf(P.w_in[(size_t)k * D_IN + GLOW_COL + j]); }
    for (int m = gw; m < M; m += NGW) {
        const GAS f32x4* xr = (const GAS f32x4*)(P.x + (size_t)m * DMODEL) + F.lane; const GAS f32x4* gr = (const GAS f32x4*)P.g1 + F.lane;
        f32x4 v[4]; float s = 0.f;
#pragma unroll
        for (int j = 0; j < 4; ++j) { v[j] = xr[64 * j]; s += (v[j].x * v[j].x + v[j].y * v[j].y) + (v[j].z * v[j].z + v[j].w * v[j].w); }
        const float rstd = rsqrtf(wave_sum(s) * (1.f / DMODEL) + 1e-6f);
        GAS unsigned long long* o8 = (GAS unsigned long long*)(XN + (size_t)m * DMODEL) + F.lane;
#pragma unroll
        for (int j = 0; j < 4; ++j) { const f32x4 g = gr[64 * j]; o8[64 * j] = (unsigned long long)pk2(v[j].x * rstd * g.x, v[j].y * rstd * g.y) | ((unsigned long long)pk2(v[j].z * rstd * g.z, v[j].w * rstd * g.w) << 32); }
    }
}
__device__ __forceinline__ void p1_glow(Frame& F, const Ptrs& P) {
    const bf16* XN = (const bf16*)(P.ws + WS_XN); const bf16* WGL = (const bf16*)(P.ws + WS_WGL); float* GLOW = (float*)(P.ws + WS_GLOW);
    const int gw = F.vcu * NWAVES + F.wave, NGW = F.G * NWAVES, rr = F.lane & 15, g = F.lane >> 4;
    for (int grp = gw; grp < M / 16; grp += NGW) {
        const bf16* ap = XN + (size_t)(grp * 16 + rr) * 1024 + 8 * g; const bf16* bp = WGL + (size_t)rr * 1024 + 8 * g;
        f32x4 acc = (f32x4){0.f, 0.f, 0.f, 0.f};
#pragma unroll 8
        for (int ks = 0; ks < 32; ++ks) { const bf16x8 a = *(const bf16x8*)(ap + 32 * ks), b = *(const bf16x8*)(bp + 32 * ks); acc = __builtin_amdgcn_mfma_f32_16x16x32_bf16(a, b, acc, 0, 0, 0); }
#pragma unroll
        for (int r = 0; r < 4; ++r) GLOW[(size_t)(grp * 16 + 4 * g + r) * 16 + rr] = acc[r];
    }
}
typedef short v4i16_t __attribute__((ext_vector_type(4)));
__device__ __forceinline__ v4i16_t tr16(const LAS unsigned char* p) { return __builtin_amdgcn_ds_read_tr16_b64_v4i16((LAS v4i16_t*)p); }
__device__ __forceinline__ float logsig(float z) { return fminf(z, 0.f) - __logf(1.0f + __expf(-fabsf(z))); }
__device__ __forceinline__ float bflo(unsigned w) { return __uint_as_float(w << 16); }
__device__ __forceinline__ float bfhi(unsigned w) { return __uint_as_float(w & 0xffff0000u); }
#define WG_BAR() do { asm volatile("s_waitcnt vmcnt(0) lgkmcnt(0)" ::: "memory"); __builtin_amdgcn_s_barrier(); asm volatile("" ::: "memory"); } while (0)
#define WG_BAR_L() do { asm volatile("s_waitcnt lgkmcnt(0)" ::: "memory"); __builtin_amdgcn_s_barrier(); asm volatile("" ::: "memory"); } while (0)

__device__ __forceinline__ void gla_scan(Frame& F, const Ptrs& P) {
    const int bh = F.vcu >> 3, ds = F.vcu & 7, b = bh >> 2, h = bh & 3;
    const bf16* GK = (const bf16*)(P.ws + WS_GK); const bf16* GV = (const bf16*)(P.ws + WS_GV); const float* GLOW = (const float*)(P.ws + WS_GLOW); bf16* ST = (bf16*)(P.ws + WS_ST);
    LAS float* LA = (LAS float*)(F.lds + RING_OFF); LAS float* KS = (LAS float*)(F.lds + RING_OFF + 4096);
    LAS unsigned char* vt = F.lds + RING_OFF + 8192 + F.wave * 5120;
    const int c = F.tid >> 3, dp = F.tid & 7, cha = h * 128 + ds * 16 + 2 * dp;
    const int ln = F.lane & 15, g = F.lane >> 4, e0 = 32 * F.wave;
    float gu0[16], gu1[16];
#pragma unroll
    for (int r = 0; r < 16; ++r) { gu0[r] = P.gup[r * 512 + cha]; gu1[r] = P.gup[r * 512 + cha + 1]; }
    const float bias0 = P.gbias[cha], bias1 = P.gbias[cha + 1];
    f32x4 acc[2]; acc[0] = (f32x4){0.f, 0.f, 0.f, 0.f}; acc[1] = acc[0];
    f32x4 gl[4]; unsigned k2; v4u vr[4];
#define G1_LOAD(n_) do { const size_t t0_ = (size_t)b * SEQ + 64 * (n_); const f32x4* gp_ = (const f32x4*)(GLOW + (t0_ + c) * 16); gl[0] = gp_[0]; gl[1] = gp_[1]; gl[2] = gp_[2]; gl[3] = gp_[3]; \
        k2 = *(const unsigned*)(GK + (t0_ + c) * 512 + cha); \
        _Pragma("unroll") for (int i_ = 0; i_ < 4; ++i_) vr[i_] = *(const v4u*)(GV + (t0_ + (F.lane >> 2) + 16 * i_) * 1024 + h * 256 + e0 + (F.lane & 3) * 8); } while (0)
    G1_LOAD(0);
    for (int n = 0; n < 64; ++n) {
        { float z0 = bias0, z1 = bias1;
#pragma unroll
          for (int r = 0; r < 16; ++r) { const float x = gl[r >> 2][r & 3]; z0 += x * gu0[r]; z1 += x * gu1[r]; }
          LA[c * 16 + 2 * dp] = logsig(z0) * 0.0625f; LA[c * 16 + 2 * dp + 1] = logsig(z1) * 0.0625f;
          KS[c * 16 + 2 * dp] = bflo(k2); KS[c * 16 + 2 * dp + 1] = bfhi(k2);
#pragma unroll
          for (int i = 0; i < 4; ++i) *(LAS v4u*)(vt + ((F.lane >> 2) + 16 * i) * 80 + (F.lane & 3) * 16) = vr[i]; }
        if (n + 1 < 64) G1_LOAD(n + 1);
        WG_BAR_L();
        float p[2][8];
#pragma unroll
        for (int ks = 0; ks < 2; ++ks) { float run = 0.f;
#pragma unroll
            for (int j = 0; j < 8; ++j) { run += LA[(32 * ks + 8 * g + j) * 16 + ln]; p[ks][j] = run; } }
        float E[2], Stot[2];
#pragma unroll
        for (int ks = 0; ks < 2; ++ks) { const float T = p[ks][7]; const float ta = __shfl(T, ln), tb = __shfl(T, ln + 16), tc = __shfl(T, ln + 32), td = __shfl(T, ln + 48);
            E[ks] = (g > 0 ? ta : 0.f) + (g > 1 ? tb : 0.f) + (g > 2 ? tc : 0.f); Stot[ks] = (ta + tb) + (tc + td); }
        E[1] += Stot[0]; const float blast = Stot[0] + Stot[1];
        bf16x8 af[2];
#pragma unroll
        for (int ks = 0; ks < 2; ++ks) { float kd[8];
#pragma unroll
            for (int j = 0; j < 8; ++j) kd[j] = KS[(32 * ks + 8 * g + j) * 16 + ln] * __expf(blast - (E[ks] + p[ks][j]));
            v4u w; w.x = pk2(kd[0], kd[1]); w.y = pk2(kd[2], kd[3]); w.z = pk2(kd[4], kd[5]); w.w = pk2(kd[6], kd[7]); af[ks] = __builtin_bit_cast(bf16x8, w); }
        const float gam = __expf(blast);
        const float g0 = __shfl(gam, 4 * g), g1 = __shfl(gam, 4 * g + 1), g2 = __shfl(gam, 4 * g + 2), g3 = __shfl(gam, 4 * g + 3);
#pragma unroll
        for (int et = 0; et < 2; ++et) {
            bf16* sp = ST + (((size_t)(bh * 64 + n) * 256 + e0 + 16 * et + ln) * 128 + 16 * ds + 4 * g);
            *(unsigned long long*)sp = (unsigned long long)pk2(acc[et][0], acc[et][1]) | ((unsigned long long)pk2(acc[et][2], acc[et][3]) << 32);
            acc[et][0] *= g0; acc[et][1] *= g1; acc[et][2] *= g2; acc[et][3] *= g3;
#pragma unroll
            for (int ks = 0; ks < 2; ++ks) {
                const LAS unsigned char* tp = vt + (32 * ks + 8 * g + (ln >> 2)) * 80 + (16 * et + 4 * (ln & 3)) * 2;
                const v4i16_t lo = tr16(tp), hi = tr16(tp + 4 * 80);
                const bf16x8 bfr = (bf16x8){lo[0], lo[1], lo[2], lo[3], hi[0], hi[1], hi[2], hi[3]};
                acc[et] = __builtin_amdgcn_mfma_f32_16x16x32_bf16(af[ks], bfr, acc[et], 0, 0, 0); }
        }
        WG_BAR_L();
    }
#undef G1_LOAD
}

constexpr int G2_QD = 0, G2_KI = 16384, G2_VT = 32768, G2_TT = 67584, G2_GL = 71680, G2_SS = 75776, G2_STG = 76288;
__device__ __forceinline__ int g2_tile_off(int row, int col) { return row * 256 + (((col >> 3) ^ (row & 15)) << 4) + (col & 7) * 2; }
__device__ __forceinline__ void gla_out_unit(Frame& F, const Ptrs& P, int b, int n, int h) {
    const bf16* GQ = (const bf16*)(P.ws + WS_GQ); const bf16* GK = (const bf16*)(P.ws + WS_GK); const bf16* GV = (const bf16*)(P.ws + WS_GV); bf16* GO = (bf16*)(P.ws + WS_GO);
    const float* GLOW = (const float*)(P.ws + WS_GLOW); const bf16* ST = (const bf16*)(P.ws + WS_ST);
    LAS unsigned char* L = F.lds + RING_OFF;
    const size_t t0 = (size_t)b * SEQ + 64 * n;
    const int cp = F.lane, tg = F.wave, ch = h * 128 + 2 * cp;
    if (F.tid < 256) *(LAS f32x4*)(L + G2_GL + F.tid * 16) = *(const f32x4*)(GLOW + t0 * 16 + F.tid * 4);
#pragma unroll
    for (int i = 0; i < 4; ++i) { const int id = F.tid + 512 * i, row = id >> 5, pc = id & 31; *(LAS v4u*)(L + G2_VT + row * 544 + pc * 16) = *(const v4u*)(GV + (t0 + row) * 1024 + h * 256 + pc * 8); }
    float gu0[16], gu1[16];
#pragma unroll
    for (int r = 0; r < 16; ++r) { gu0[r] = P.gup[r * 512 + ch]; gu1[r] = P.gup[r * 512 + ch + 1]; }
    const float bias0 = P.gbias[ch], bias1 = P.gbias[ch + 1];
    unsigned q2[8], k2[8];
#pragma unroll
    for (int j = 0; j < 8; ++j) { q2[j] = *(const unsigned*)(GQ + (t0 + 8 * tg + j) * 512 + ch); k2[j] = *(const unsigned*)(GK + (t0 + 8 * tg + j) * 512 + ch); }
    WG_BAR();
    float p0[8], p1[8];
    { float r0 = 0.f, r1 = 0.f;
#pragma unroll
      for (int j = 0; j < 8; ++j) { const LAS f32x4* gp = (const LAS f32x4*)(L + G2_GL + (8 * tg + j) * 64); float z0 = bias0, z1 = bias1;
#pragma unroll
          for (int q = 0; q < 4; ++q) { const f32x4 x = gp[q];
#pragma unroll
              for (int e = 0; e < 4; ++e) { z0 += x[e] * gu0[4 * q + e]; z1 += x[e] * gu1[4 * q + e]; } }
          r0 += logsig(z0) * 0.0625f; r1 += logsig(z1) * 0.0625f; p0[j] = r0; p1[j] = r1; }
      *(LAS float*)(L + G2_TT + (tg * 128 + 2 * cp) * 4) = r0; *(LAS float*)(L + G2_TT + (tg * 128 + 2 * cp + 1) * 4) = r1; }
    WG_BAR_L();
    { float E0 = 0.f, E1 = 0.f;
#pragma unroll
      for (int t = 0; t < 7; ++t) if (t < tg) { E0 += *(LAS float*)(L + G2_TT + (t * 128 + 2 * cp) * 4); E1 += *(LAS float*)(L + G2_TT + (t * 128 + 2 * cp + 1) * 4); }
      const float qs = 0.08838834764831845f;
#pragma unroll
      for (int j = 0; j < 8; ++j) { const float b0 = E0 + p0[j], b1 = E1 + p1[j]; const float e0 = __expf(b0), e1 = __expf(b1), i0 = __expf(-b0), i1 = __expf(-b1);
          const int off = g2_tile_off(8 * tg + j, 2 * cp);
          *(LAS unsigned*)(L + G2_QD + off) = pk2(bflo(q2[j]) * qs * e0, bfhi(q2[j]) * qs * e1);
          *(LAS unsigned*)(L + G2_KI + off) = pk2(bflo(k2[j]) * i0, bfhi(k2[j]) * i1); } }
    WG_BAR_L();
    const int jt = F.wave & 3, eh = F.wave >> 2, ln = F.lane & 15, g = F.lane >> 4;
    bf16x8 bqd[4];
#pragma unroll
    for (int ks = 0; ks < 4; ++ks) bqd[ks] = *(const LAS bf16x8*)(L + G2_QD + g2_tile_off(16 * jt + ln, 32 * ks + 8 * g));
    unsigned pk[4][2];
#pragma unroll
    for (int i = 0; i < 4; ++i) { f32x4 s = (f32x4){0.f, 0.f, 0.f, 0.f};
#pragma unroll
        for (int ks = 0; ks < 4; ++ks) { const bf16x8 a = *(const LAS bf16x8*)(L + G2_KI + g2_tile_off(16 * i + ln, 32 * ks + 8 * g)); s = __builtin_amdgcn_mfma_f32_16x16x32_bf16(a, bqd[ks], s, 0, 0, 0); }
        const int cq = 16 * jt + ln, ck = 16 * i + 4 * g;
        pk[i][0] = pk2(ck + 0 <= cq ? s[0] : 0.f, ck + 1 <= cq ? s[1] : 0.f); pk[i][1] = pk2(ck + 2 <= cq ? s[2] : 0.f, ck + 3 <= cq ? s[3] : 0.f); }
    bf16x8 apk[2];
#pragma unroll
    for (int k2i = 0; k2i < 2; ++k2i) { v4u w; w.x = pk[2 * k2i][0]; w.y = pk[2 * k2i][1]; w.z = pk[2 * k2i + 1][0]; w.w = pk[2 * k2i + 1][1]; apk[k2i] = __builtin_bit_cast(bf16x8, w); }
    f32x4 o[8];
    const bf16* stp = ST + (((size_t)((b * 4 + h) * 64 + n) * 256 + 128 * eh + ln) * 128 + 8 * g);
#pragma unroll
    for (int et = 0; et < 8; ++et) { f32x4 a = (f32x4){0.f, 0.f, 0.f, 0.f};
        bf16x8 bst[4];
#pragma unroll
        for (int ks = 0; ks < 4; ++ks) bst[ks] = *(const bf16x8*)(stp + (size_t)(16 * et) * 128 + 32 * ks);
#pragma unroll
        for (int k2i = 0; k2i < 2; ++k2i) { const LAS unsigned char* tp = L + G2_VT + (32 * k2i + 4 * g + (ln >> 2)) * 544 + (128 * eh + 16 * et + 4 * (ln & 3)) * 2;
            const v4i16_t lo = tr16(tp), hi = tr16(tp + 16 * 544);
            a = __builtin_amdgcn_mfma_f32_16x16x32_bf16(apk[k2i], (bf16x8){lo[0], lo[1], lo[2], lo[3], hi[0], hi[1], hi[2], hi[3]}, a, 0, 0, 0); }
#pragma unroll
        for (int ks = 0; ks < 4; ++ks) a = __builtin_amdgcn_mfma_f32_16x16x32_bf16(bqd[ks], bst[ks], a, 0, 0, 0);
        o[et] = a; }
    float ssr[4];
#pragma unroll
    for (int r = 0; r < 4; ++r) { float s = 0.f;
#pragma unroll
        for (int et = 0; et < 8; ++et) s += o[et][r] * o[et][r];
        s += __shfl_xor(s, 1); s += __shfl_xor(s, 2); s += __shfl_xor(s, 4); s += __shfl_xor(s, 8); ssr[r] = s; }
    if (ln == 0) {
#pragma unroll
        for (int r = 0; r < 4; ++r) *(LAS float*)(L + G2_SS + (eh * 64 + 16 * jt + 4 * g + r) * 4) = ssr[r]; }
    WG_BAR_L();
#pragma unroll
    for (int r = 0; r < 4; ++r) { const int row = 16 * jt + 4 * g + r; const float tot = *(LAS float*)(L + G2_SS + row * 4) + *(LAS float*)(L + G2_SS + (64 + row) * 4);
        const float rstd = rsqrtf(tot * (1.0f / 256.0f) + 1e-6f);
#pragma unroll
        for (int et = 0; et < 8; ++et) *(LAS unsigned short*)(L + G2_STG + row * 528 + (128 * eh + 16 * et + ln) * 2) = (unsigned short)f2bf(o[et][r] * rstd); }
    WG_BAR_L();
    { const int row = F.tid >> 3;
#pragma unroll
      for (int i = 0; i < 4; ++i) { const int chn = (F.tid & 7) + 8 * i; const v4u y = *(const LAS v4u*)(L + G2_STG + row * 528 + chn * 16);
          bf16* gop = GO + (t0 + row) * 1024 + h * 256 + chn * 8; const v4u go = *(const v4u*)gop; const f32x4 ga = *(const f32x4*)(P.gnorm + chn * 8), gb = *(const f32x4*)(P.gnorm + chn * 8 + 4);
          v4u w; w.x = pk2(bflo(y.x) * ga[0] * bflo(go.x), bfhi(y.x) * ga[1] * bfhi(go.x)); w.y = pk2(bflo(y.y) * ga[2] * bflo(go.y), bfhi(y.y) * ga[3] * bfhi(go.y));
          w.z = pk2(bflo(y.z) * gb[0] * bflo(go.z), bfhi(y.z) * gb[1] * bfhi(go.z)); w.w = pk2(bflo(y.w) * gb[2] * bflo(go.w), bfhi(y.w) * gb[3] * bfhi(go.w));
          *(v4u*)gop = w; } }
    WG_BAR_L();
}
namespace moba {
using bf16x8 = __attribute__((ext_vector_type(8))) short;
using s16x4 = __attribute__((ext_vector_type(4))) short;
using f32x16 = __attribute__((ext_vector_type(16))) float;
using u32x4 = __attribute__((ext_vector_type(4))) unsigned;
typedef unsigned short bf16;
constexpr int DM = 512, D = 64, QB = 256, KVBLK = 64, SLOTB = 8192;
constexpr int L_K = 0, L_V = 16384, L_WS = 32768, L_OST = 34816, L_TB = 67584, L_SEL = 68608, L_KM = 69632;
constexpr float LOG2E = 1.4426950408889634f, NEGBIG = -1.0e30f;
__device__ __forceinline__ int crow(int r, int hi) { return (r & 3) + 8 * (r >> 2) + 4 * hi; }
__device__ __forceinline__ void glds16(const void* gsrc, unsigned lds_dst) { unsigned keep;
    asm volatile("s_mov_b32 %0, m0\n\ts_mov_b32 m0, %2\n\ts_nop 0\n\tglobal_load_lds_dwordx4 %1, off\n\ts_mov_b32 m0, %0" : "=&s"(keep) : "v"(gsrc), "s"(lds_dst) : "memory"); }
__device__ __forceinline__ unsigned cvtpk_s(float lo, float hi) { typedef float f32x2_t __attribute__((ext_vector_type(2))); typedef __bf16 bf16x2_t __attribute__((ext_vector_type(2)));
    f32x2_t v = {lo, hi}; bf16x2_t b = __builtin_convertvector(v, bf16x2_t); return __builtin_bit_cast(unsigned, b); }
#define MB_WAIT_BAR() asm volatile("s_waitcnt vmcnt(0) lgkmcnt(0)\n\ts_barrier" ::: "memory")
__device__ __forceinline__ void qkt(f32x16& p0, f32x16& p1, const LAS unsigned char* Kslot, const bf16x8* qr, int r32, int hi) {
    const LAS unsigned char* kb = Kslot + hi * 1024 + r32 * 16;
    p0 = f32x16{}; p1 = f32x16{};
#pragma unroll
    for (int d0 = 0; d0 < 4; ++d0) {
        const bf16x8 b0 = *(const LAS bf16x8*)(kb + d0 * 2048);
        const bf16x8 b1 = *(const LAS bf16x8*)(kb + d0 * 2048 + 512);
        p0 = __builtin_amdgcn_mfma_f32_32x32x16_bf16(b0, qr[d0], p0, 0, 0, 0); p1 = __builtin_amdgcn_mfma_f32_32x32x16_bf16(b1, qr[d0], p1, 0, 0, 0); }
}
__device__ __forceinline__ float rowmax(const f32x16& p0, const f32x16& p1) {
    float a = fmaxf(p0[0], p1[0]);
#pragma unroll
    for (int r = 1; r < 16; ++r) a = fmaxf(a, fmaxf(p0[r], p1[r]));
    auto rr = __builtin_amdgcn_permlane32_swap(__float_as_uint(a), __float_as_uint(a), false, false);
    return fmaxf(__uint_as_float(rr[0]), __uint_as_float(rr[1]));
}
__device__ __forceinline__ void pv(f32x16* o, int vb, bf16x8 pa0, bf16x8 pa1, bf16x8 pa2, bf16x8 pa3) {
#pragma unroll
    for (int d0 = 0; d0 < 2; ++d0) { s16x4 lo[4], hi[4];
#pragma unroll
        for (int ks = 0; ks < 4; ++ks) {
            asm volatile("ds_read_b64_tr_b16 %0,%1 offset:%c2" : "=&v"(lo[ks]) : "v"(vb), "i"(d0 * 4096 + ks * 1024) : "memory");
            asm volatile("ds_read_b64_tr_b16 %0,%1 offset:%c2" : "=&v"(hi[ks]) : "v"(vb), "i"(d0 * 4096 + ks * 1024 + 512) : "memory"); }
        asm volatile("s_waitcnt lgkmcnt(0)" ::: "memory"); __builtin_amdgcn_sched_barrier(0);
#define MB_PK(k) (bf16x8){lo[k][0], lo[k][1], lo[k][2], lo[k][3], hi[k][0], hi[k][1], hi[k][2], hi[k][3]}
        o[d0] = __builtin_amdgcn_mfma_f32_32x32x16_bf16(pa0, MB_PK(0), o[d0], 0, 0, 0);
        o[d0] = __builtin_amdgcn_mfma_f32_32x32x16_bf16(pa1, MB_PK(1), o[d0], 0, 0, 0);
        o[d0] = __builtin_amdgcn_mfma_f32_32x32x16_bf16(pa2, MB_PK(2), o[d0], 0, 0, 0);
        o[d0] = __builtin_amdgcn_mfma_f32_32x32x16_bf16(pa3, MB_PK(3), o[d0], 0, 0, 0);
#undef MB_PK
    }
}
__device__ __forceinline__ int t5_bucket(int d) {
    if (d < 16) return d;
    const int large = 16 + (int)(__logf((float)d * (1.0f / 16.0f)) / 2.0794415416798357f * 16.0f);
    return large < 31 ? large : 31;
}
__device__ __forceinline__ void attn_unit(int b, int h, int qb, bf16* Q, const bf16* __restrict__ K, const bf16* __restrict__ V, const float* kmean, const float* t5, LAS unsigned char* shm) {
    const int tid = threadIdx.x, lane = tid & 63, r32 = lane & 31, hi = lane >> 5; const int wid = __builtin_amdgcn_readfirstlane(tid >> 6);
    const long rowbase = (long)b * SEQ; const int q0 = qb * QB;
    const bf16* Qw = Q + (rowbase + q0 + wid * 32) * DM + h * D;
    const bf16* Kh = K + rowbase * DM + h * D; const bf16* Vh = V + rowbase * DM + h * D;
    const unsigned lds0 = (unsigned)(uintptr_t)shm;
    LAS float* wsf = (LAS float*)(shm + L_WS) + wid * 64;
    LAS float* TB = (LAS float*)(shm + L_TB); LAS unsigned* SEL = (LAS unsigned*)(shm + L_SEL); LAS float* KM = (LAS float*)(shm + L_KM);
    const bf16* ksrc = Kh + (long)lane * DM + wid * 8;
    const bf16* vsrc = Vh + (long)(16 * (wid & 3) + (lane >> 2)) * DM + (wid >> 2) * 32 + (lane & 3) * 8;
    const unsigned kdst = lds0 + L_K + wid * 1024, vdst = lds0 + L_V + wid * 1024;
#define DMA_K(t, slot) glds16(ksrc + (long)(t) * KVBLK * DM, (unsigned)__builtin_amdgcn_readfirstlane(kdst + (slot)))
#define DMA_V(t, slot) glds16(vsrc + (long)(t) * KVBLK * DM, (unsigned)__builtin_amdgcn_readfirstlane(vdst + (slot)))
#define PHYS(t) ((t) < 4 ? 4 * qb + (t) : (t) - 4)
    const int vb0 = (int)(lds0 + L_V) + ((lane >> 4) & 1) * 32 + (lane & 3) * 8 + (4 * hi + ((lane & 15) >> 2)) * 64;
    const int NT = 4 * (qb + 1);
    DMA_K(PHYS(0), 0); DMA_V(PHYS(0), 0);
    if (tid <= 128) TB[tid] = t5[t5_bucket(tid) * 8 + h] * LOG2E;
    for (int idx = tid; idx < qb * 64; idx += 512) KM[idx] = kmean[((size_t)(b * 16 + (idx >> 6)) * 8 + h) * 64 + (idx & 63)];
    bf16x8 qr[4];
#pragma unroll
    for (int d0 = 0; d0 < 4; ++d0) qr[d0] = *reinterpret_cast<const bf16x8*>(&Qw[(long)r32 * DM + d0 * 16 + hi * 8]);
    asm volatile("s_waitcnt lgkmcnt(0)\n\ts_barrier" ::: "memory");
    if (tid < 256) {
        const bf16* qrow = Q + (rowbase + q0 + tid) * DM + h * D;
        float gj[15];
#pragma unroll
        for (int j = 0; j < 15; ++j) gj[j] = 0.f;
#pragma unroll
        for (int c8 = 0; c8 < 8; ++c8) { const u32x4 w = *(const u32x4*)(qrow + 8 * c8);
            const float q[8] = {__uint_as_float(w.x << 16), __uint_as_float(w.x & 0xffff0000u), __uint_as_float(w.y << 16), __uint_as_float(w.y & 0xffff0000u), __uint_as_float(w.z << 16), __uint_as_float(w.z & 0xffff0000u), __uint_as_float(w.w << 16), __uint_as_float(w.w & 0xffff0000u)};
#pragma unroll
            for (int j = 0; j < 15; ++j) if (j < qb) { const f32x4 ka = *(const LAS f32x4*)(KM + j * 64 + 8 * c8), kb = *(const LAS f32x4*)(KM + j * 64 + 8 * c8 + 4);
                gj[j] += (q[0] * ka[0] + q[1] * ka[1]) + (q[2] * ka[2] + q[3] * ka[3]) + (q[4] * kb[0] + q[5] * kb[1]) + (q[6] * kb[2] + q[7] * kb[3]); } }
        float v1 = -INFINITY, v2 = -INFINITY, v3 = -INFINITY; int i1 = -1, i2 = -1, i3 = -1;
#pragma unroll
        for (int j = 0; j < 15; ++j) if (j < qb) { const float x = gj[j];
            if (x > v1) { v3 = v2; i3 = i2; v2 = v1; i2 = i1; v1 = x; i1 = j; } else if (x > v2) { v3 = v2; i3 = i2; v2 = x; i2 = j; } else if (x > v3) { v3 = x; i3 = j; } }
        SEL[tid] = (i1 >= 0 ? 1u << i1 : 0u) | (i2 >= 0 ? 1u << i2 : 0u) | (i3 >= 0 ? 1u << i3 : 0u);
    }
    asm volatile("s_waitcnt lgkmcnt(0)\n\ts_barrier" ::: "memory");
    const unsigned selm = SEL[wid * 32 + r32];
    const int qrel = wid * 32 + r32; const float tb128 = TB[128];
    float m_run = -3.0e38f, l_reg = 0.f; f32x16 o[2]; o[0] = f32x16{}; o[1] = f32x16{};
    for (int t = 0; t < NT; ++t) {
        MB_WAIT_BAR();
        if (t + 1 < NT) { DMA_K(PHYS(t + 1), ((t + 1) & 1) * SLOTB); DMA_V(PHYS(t + 1), ((t + 1) & 1) * SLOTB); }
        const int slot = (t & 1) * SLOTB;
        f32x16 p0, p1;
        qkt(p0, p1, shm + L_K + slot, qr, r32, hi);
        if (t < 4) {
#pragma unroll
            for (int r = 0; r < 16; ++r) { const int d0 = qrel - (64 * t + crow(r, hi)), d1 = d0 - 32;
                p0[r] = d0 >= 0 ? p0[r] + TB[d0 < 128 ? d0 : 128] : NEGBIG; p1[r] = d1 >= 0 ? p1[r] + TB[d1 < 128 ? d1 : 128] : NEGBIG; }
        } else {
            const int blk = (t - 4) >> 2; const bool sel = (selm >> blk) & 1u;
            if (blk == qb - 1) {
                const int jb = (t - 4) & 3;
#pragma unroll
                for (int r = 0; r < 16; ++r) { const int d0 = qrel + 256 - (64 * jb + crow(r, hi)), d1 = d0 - 32;
                    p0[r] = sel ? p0[r] + TB[d0 < 128 ? d0 : 128] : NEGBIG; p1[r] = sel ? p1[r] + TB[d1 < 128 ? d1 : 128] : NEGBIG; }
            } else {
#pragma unroll
                for (int r = 0; r < 16; ++r) { p0[r] = sel ? p0[r] + tb128 : NEGBIG; p1[r] = sel ? p1[r] + tb128 : NEGBIG; }
            }
        }
        const float rm = rowmax(p0, p1);
        const float mnew = fmaxf(m_run, rm); const float f = __builtin_amdgcn_exp2f(m_run - mnew); m_run = mnew;
        float sacc = 0.f;
#pragma unroll
        for (int r = 0; r < 16; ++r) { p0[r] = __builtin_amdgcn_exp2f(p0[r] - mnew); p1[r] = __builtin_amdgcn_exp2f(p1[r] - mnew); sacc += p0[r] + p1[r]; }
        l_reg = l_reg * f + sacc;
        if (hi == 0) wsf[r32] = f;
        asm volatile("s_waitcnt lgkmcnt(0)" ::: "memory");
#pragma unroll
        for (int r = 0; r < 16; ++r) { const float fr = wsf[crow(r, hi)]; o[0][r] *= fr; o[1][r] *= fr; }
        u32x4 pw0, pw1, pw2, pw3;
        pw0 = (u32x4){cvtpk_s(p0[0], p0[1]), cvtpk_s(p0[2], p0[3]), cvtpk_s(p0[4], p0[5]), cvtpk_s(p0[6], p0[7])};
        pw1 = (u32x4){cvtpk_s(p0[8], p0[9]), cvtpk_s(p0[10], p0[11]), cvtpk_s(p0[12], p0[13]), cvtpk_s(p0[14], p0[15])};
        pw2 = (u32x4){cvtpk_s(p1[0], p1[1]), cvtpk_s(p1[2], p1[3]), cvtpk_s(p1[4], p1[5]), cvtpk_s(p1[6], p1[7])};
        pw3 = (u32x4){cvtpk_s(p1[8], p1[9]), cvtpk_s(p1[10], p1[11]), cvtpk_s(p1[12], p1[13]), cvtpk_s(p1[14], p1[15])};
        asm volatile("s_waitcnt lgkmcnt(0)" ::: "memory"); __builtin_amdgcn_sched_barrier(0);
        pv(o, vb0 + slot, __builtin_bit_cast(bf16x8, pw0), __builtin_bit_cast(bf16x8, pw1), __builtin_bit_cast(bf16x8, pw2), __builtin_bit_cast(bf16x8, pw3));
    }
    { auto rr = __builtin_amdgcn_permlane32_swap(__float_as_uint(l_reg), __float_as_uint(l_reg), false, false); l_reg = __uint_as_float(rr[0]) + __uint_as_float(rr[1]); }
    if (hi == 0) wsf[32 + r32] = l_reg;
    asm volatile("s_waitcnt lgkmcnt(0)" ::: "memory");
    float rli[16];
#pragma unroll
    for (int r = 0; r < 16; ++r) rli[r] = __builtin_amdgcn_rcpf(wsf[32 + crow(r, hi)]);
    bf16* Ow = Q + (rowbase + q0 + wid * 32) * DM + h * D;
    { LAS bf16* stg = (LAS bf16*)(shm + L_OST) + wid * 2048;
#pragma unroll
      for (int r = 0; r < 16; ++r) { const int orow = crow(r, hi);
#pragma unroll
          for (int d0 = 0; d0 < 2; ++d0) stg[orow * 64 + d0 * 32 + r32] = (bf16)f2bf(o[d0][r] * rli[r]); }
      asm volatile("s_waitcnt lgkmcnt(0)" ::: "memory");
#pragma unroll
      for (int i = 0; i < 4; ++i) { const int row = i * 8 + (lane >> 3), ch = lane & 7; const u32x4 v = *(const LAS u32x4*)(stg + row * 64 + ch * 8); *(u32x4*)(Ow + (long)row * DM + ch * 8) = v; } }
    asm volatile("s_waitcnt vmcnt(0) lgkmcnt(0)\n\ts_barrier" ::: "memory");
#undef DMA_K
#undef DMA_V
#undef PHYS
}
}
#ifndef SKIP_MOBA
#define SKIP_MOBA 0
#endif
struct Args { const float* in[15]; float* out; unsigned char* ws; int ph_lo, ph_hi; };
__global__ void __launch_bounds__(NWAVES * 64, 2) hybrid_fwd(Args args) {
    extern __shared__ __attribute__((aligned(16))) unsigned char lds[];
    Frame F;
    F.lds = (LAS unsigned char*)lds;
    F.MISC = (volatile LAS unsigned*)(F.lds + MISC_OFF);
    F.tid = threadIdx.x; F.lane = F.tid & 63; F.wave = __builtin_amdgcn_readfirstlane(F.tid >> 6);
    F.G = gridDim.x; { const int bx = blockIdx.x; F.vcu = (F.G % 8 == 0) ? (bx % 8) * (F.G / 8) + bx / 8 : bx; }
    unsigned char* ws = args.ws;
    F.ctl = (gu32*)(ws + WS_CTL);
    Ptrs P;
    P.x = args.in[0]; P.g1 = args.in[1]; P.w_in = args.in[2]; P.qg = args.in[3]; P.kg = args.in[4]; P.t5 = args.in[5]; P.gup = args.in[6]; P.gbias = args.in[7];
    P.gnorm = args.in[8]; P.wba = args.in[9]; P.wbg = args.in[10]; P.wout = args.in[11]; P.g2 = args.in[12]; P.wup = args.in[13]; P.wdn = args.in[14]; P.out = args.out; P.ws = ws;
    for (int u = F.tid; u < (LDS_BYTES - LDSCTL_OFF) / 4; u += NWAVES * 64) ((LAS unsigned*)(F.lds + LDSCTL_OFF))[u] = 0u;
    __syncthreads();
    XcdBarrier bar; bar.bar = (unsigned*)(F.ctl + CW_BAR); bar.x = 0; bar.st = nullptr;
    if (N_LAUNCHES == 1) bar = xcd_barrier_post((unsigned*)(F.ctl + CW_BAR), F.MISC + 8);
#define GRID_BAR() do { if (N_LAUNCHES == 1) xcd_barrier(bar); } while (0)
    const int lo = args.ph_lo, hi = args.ph_hi;
#define IN(k) (lo <= (k) && (k) < hi)
#define BOTH(k) (IN(k) && IN((k) + 1))
    bf16* XN = (bf16*)(ws + WS_XN); bf16* H1B = (bf16*)(ws + WS_H1B); bf16* HB = (bf16*)(ws + WS_HB); float* SSQ = (float*)(ws + WS_SSQ);
    bf16* QB_ = (bf16*)(ws + WS_Q); bf16* KB_ = (bf16*)(ws + WS_K); bf16* VB_ = (bf16*)(ws + WS_V); bf16* GO_ = (bf16*)(ws + WS_GO); bf16* MIX = (bf16*)(ws + WS_MIX);
    bf16* SA = (bf16*)P.out; bf16* SG = (bf16*)P.out + (size_t)M * 1024;
    float* KMEAN = (float*)(ws + WS_KMEAN);

    if (IN(0)) { p0_prologue(F, P); if (BOTH(0)) GRID_BAR(); }
    if (IN(1)) {
        pg8::Gemm g{XN, (const bf16*)(ws + WS_WIN), M, NPROJ, DMODEL}; pg8::StaticOrder S; S.init(M, NPROJ, F.G, (int)blockIdx.x);
        pg8::EpiProj E{QB_, KB_, VB_, (bf16*)(ws + WS_GV), SA, KMEAN, P.qg, P.kg};
        static_assert(WS_GQ == WS_V + 32 * MiB && WS_GK == WS_V + 64 * MiB && WS_GO == WS_GV + 64 * MiB, "EpiProj strides");
        pg8::gemm_phase<pg8::EpiProj, pg8::StaticOrder, true, true>(F.lds + RING_OFF, g, S, E);
        p1_glow(F, P);
        if (BOTH(1)) GRID_BAR();
    }
    if (IN(2)) { if (F.G == 256) gla_scan(F, P); if (BOTH(2)) GRID_BAR(); }
    if (IN(3)) {
        if (F.G == 256) {
#if !SKIP_MOBA
            { const int bh = F.vcu >> 2, s = F.vcu & 3;
              for (int i = 0; i < 4; ++i) { const int qb = (i == 0) ? s : (i == 1) ? 7 - s : (i == 2) ? 8 + s : 15 - s;
                  moba::attn_unit(bh >> 3, bh & 7, qb, QB_, KB_, VB_, KMEAN, P.t5, F.lds + RING_OFF); } }
#endif
            for (int i = 0; i < 8; ++i) { const int U = F.vcu * 8 + i; gla_out_unit(F, P, U >> 8, (U >> 2) & 63, U & 3); }
        }
        if (BOTH(3)) GRID_BAR();
    }
    if (IN(4)) {
        { pg8::Gemm g{QB_, (const bf16*)(ws + WS_WBA), M, DMODEL, 512}; pg8::StaticOrder S; S.init(M, DMODEL, F.G, (int)blockIdx.x);
          pg8::EpiMix<false> E{SA, MIX};
          pg8::gemm_phase<pg8::EpiMix<false>, pg8::StaticOrder, true, true>(F.lds + RING_OFF, g, S, E); }
        { pg8::Gemm g{GO_, (const bf16*)(ws + WS_WBG), M, DMODEL, DMODEL}; pg8::StaticOrder S; S.init(M, DMODEL, F.G, (int)blockIdx.x);
          pg8::EpiMix<true> E{SG, MIX};
          pg8::gemm_phase<pg8::EpiMix<true>, pg8::StaticOrder, true, true>(F.lds + RING_OFF, g, S, E); }
        if (BOTH(4)) GRID_BAR();
    }
    if (IN(5)) {
        pg8::Gemm g{MIX, (const bf16*)(ws + WS_WOUT), M, DMODEL, DMODEL}; pg8::StaticOrder S; S.init(M, DMODEL, F.G, (int)blockIdx.x);
        pg8::EpiWout E{P.x, P.out, H1B, SSQ};
        pg8::gemm_phase<pg8::EpiWout, pg8::StaticOrder, true, true>(F.lds + RING_OFF, g, S, E);
        if (BOTH(5)) GRID_BAR();
    }
    if (IN(6)) {
        pg8::Gemm g{H1B, (const bf16*)(ws + WS_WUP), M, FF, DMODEL}; pg8::StaticOrder S; S.init(M, FF, F.G, (int)blockIdx.x);
        pg8::EpiUp E{SSQ, HB};
        pg8::gemm_phase<pg8::EpiUp, pg8::StaticOrder, true, true>(F.lds + RING_OFF, g, S, E);
        if (BOTH(6)) GRID_BAR();
    }
    if (IN(7)) {
        pg8::Gemm g{HB, (const bf16*)(ws + WS_WDN), M, DMODEL, FF}; pg8::StaticOrder S; S.init(M, DMODEL, F.G, (int)blockIdx.x);
        pg8::EpiDown E{P.out};
        pg8::gemm_phase<pg8::EpiDown, pg8::StaticOrder, true, true>(F.lds + RING_OFF, g, S, E);
    }
#undef IN
#undef BOTH
}
extern "C" void kernel_launch(void* const* d_in, const int* in_sizes, int n_in, void* d_out, int out_size, void* d_ws, size_t ws_size, hipStream_t stream) {
    static int grid = 0;
    if (grid == 0) {
        if (n_in != 15 || in_sizes[0] != M * DMODEL || out_size != M * DMODEL || ws_size < WS_END) { fprintf(stderr, "kernel_launch: unexpected shapes/workspace (n_in %d, in0 %d, out %d, ws %zu)\n", n_in, n_in > 0 ? in_sizes[0] : -1, out_size, ws_size); grid = -1; return; }
        int dev = 0, cus = 0, per_cu = 0;
        if (hipGetDevice(&dev) != hipSuccess || hipDeviceGetAttribute(&cus, hipDeviceAttributeMultiprocessorCount, dev) != hipSuccess) { grid = -1; return; }
        if (hipFuncSetAttribute((const void*)hybrid_fwd, hipFuncAttributeMaxDynamicSharedMemorySize, LDS_BYTES) != hipSuccess) { fprintf(stderr, "kernel_launch: hipFuncSetAttribute failed\n"); grid = -1; return; }
        if (hipOccupancyMaxActiveBlocksPerMultiprocessor(&per_cu, (const void*)hybrid_fwd, NWAVES * 64, LDS_BYTES) != hipSuccess || per_cu < 1)
            fprintf(stderr, "kernel_launch: note: occupancy query reports %d workgroups per CU\n", per_cu);
        (void)hipGetLastError();
        grid = cus;
        if (grid != 256) fprintf(stderr, "kernel_launch: %d CUs (built for 256)\n", grid);
    }
    if (grid < 0) return;
    if (hipMemsetAsync((char*)d_ws + WS_CTL, 0, CTL_ZERO_BYTES, stream) != hipSuccess) { fprintf(stderr, "kernel_launch: hipMemsetAsync failed\n"); return; }
    Args a{};
    for (int i = 0; i < 15; ++i) a.in[i] = (const float*)d_in[i];
    a.out = (float*)d_out; a.ws = (unsigned char*)d_ws;
    for (int li = 0; li < N_LAUNCHES; ++li) {
        a.ph_lo = (N_LAUNCHES == 1) ? 0 : li; a.ph_hi = (N_LAUNCHES == 1) ? N_PHASES : li + 1;
        hipLaunchKernelGGL(hybrid_fwd, dim3(grid), dim3(NWAVES * 64), LDS_BYTES, stream, a);
        const hipError_t le = hipPeekAtLastError();
        if (le != hipSuccess) { fprintf(stderr, "kernel_launch: launch %d failed: %s\n", li, hipGetErrorName(le)); break; }
    }
}
```

```cpp
#include <hip/hip_runtime.h>
#include <hip/hip_bf16.h>
#include <cstdio>
#include <cstdint>
#include <cmath>
namespace pg8 {
#define PG8_LAS __attribute__((address_space(3)))
typedef unsigned short bf16_t;
typedef short bf16x8 __attribute__((ext_vector_type(8)));
typedef float f32x4 __attribute__((ext_vector_type(4)));
typedef unsigned u32x4 __attribute__((ext_vector_type(4)));
constexpr int BM = 256, BK = 64, HALF = 128, HTB = HALF * BK * 2  , STAGE_BYTES = 8 * HTB, NXCD = 8, WGM = 4;

__host__ __device__ __forceinline__ int lds_byte(int r, int c) { const int st = (r >> 4) * 2 + (c >> 5), rr = r & 15, cc = c & 31, ob = rr * 64 + cc * 2; return st * 1024 + (ob ^ (((ob >> 9) & 1) << 5)); }
__host__ __device__ __forceinline__ void stage_rc(int b, int& R, int& C) { const int st = b / 1024, sb = b % 1024, swz = sb ^ (((sb >> 9) & 1) << 5); R = (st >> 1) * 16 + swz / 64; C = (st & 1) * 32 + (swz % 64) / 2; }
__host__ __device__ __forceinline__ int perm32(int rho) { const int n = rho >> 4, i = rho & 15; return 8 * (i >> 2) + 4 * n + (i & 3); }

struct Unit { int pm, pn; };
struct Gemm { const bf16_t* A; const bf16_t* Bt; int M, N, K; };

struct StaticOrder {
    int nM, nN, nwg, G, c;
    __host__ __device__ void init(int M, int N, int G_, int c_) { nM = M / BM; nN = N / BM; nwg = nM * nN; G = G_; c = c_; }
    __host__ __device__ bool next(int i, Unit& u) const {
        const long L = (long)i * G + c; if (L >= nwg) return false;
        int wgid = (int)L; { const int q = nwg / NXCD, r = nwg % NXCD, xcd = wgid % NXCD, off = wgid / NXCD; wgid = (xcd < r ? xcd * (q + 1) : r * (q + 1) + (xcd - r) * q) + off; }
        const int nig = WGM * nN, gid = wgid / nig, fm = gid * WGM, gsz = (nM - fm) < WGM ? (nM - fm) : WGM;
        u.pm = fm + ((wgid % nig) % gsz); u.pn = (wgid % nig) / gsz; return true;
    }
    __device__ __forceinline__ void a_ready(const Unit&) const {}
    __device__ __forceinline__ void done(const Unit&) const {}
};
struct StaticOrderRev : StaticOrder {
    int nr;
    __host__ __device__ void init(int M, int N, int G_, int c_) { StaticOrder::init(M, N, G_, c_); nr = (nwg + G - 1) / G; }
    __host__ __device__ bool next(int i, Unit& u) const { if (i >= nr) return false; return StaticOrder::next(nr - 1 - i, u); }
};

__device__ __forceinline__ unsigned cvt_pk_bf16(float lo, float hi) { unsigned r; asm volatile("v_cvt_pk_bf16_f32 %0, %1, %2" : "=v"(r) : "v"(lo), "v"(hi)); return r; }
typedef float f32x2 __attribute__((ext_vector_type(2)));
constexpr float RMS_EPS = 1e-6f;
constexpr float QC2 = 0.125f * 1.4426950408889634f;
struct EpiCtx { PG8_LAS unsigned char* stg; bool has_next; Unit nxt; int ui; };
__device__ __forceinline__ float bflo(unsigned w) { return __uint_as_float(w << 16); }
__device__ __forceinline__ float bfhi(unsigned w) { return __uint_as_float(w & 0xffff0000u); }
__device__ __forceinline__ float sigm(float v) { return __builtin_amdgcn_rcpf(1.0f + __expf(-v)); }
__device__ __forceinline__ u32x4 pack8(const f32x4& v0, const f32x4& v1) { u32x4 w; w.x = cvt_pk_bf16(v0[0], v0[1]); w.y = cvt_pk_bf16(v0[2], v0[3]); w.z = cvt_pk_bf16(v1[0], v1[1]); w.w = cvt_pk_bf16(v1[2], v1[3]); return w; }
__device__ __forceinline__ void stage_store(const u32x4 w, int it, PG8_LAS unsigned char* stg, int wr, int wc, int fr, int fq, bf16_t* rowp0, int pitch) {
    PG8_LAS unsigned char* slab = stg + (it & 1) * 8704;
    *(PG8_LAS u32x4*)(slab + (wr * 16 + fr) * 272 + (wc * 32 + 8 * fq) * 2) = w;
    asm volatile("s_waitcnt lgkmcnt(0)" ::: "memory"); __builtin_amdgcn_s_barrier(); asm volatile("" ::: "memory");
    const int r = threadIdx.x >> 4, c = threadIdx.x & 15;
    const u32x4 v = *(const PG8_LAS u32x4*)(slab + r * 272 + c * 16);
    __builtin_nontemporal_store(v, (u32x4*)(rowp0 + (size_t)(64 * (r >> 4) + (r & 15)) * pitch + 8 * c));
}

struct EpiProj {
    static constexpr bool PERM = true, AFTER_DRAIN = false, HAS_MID = false;
    bf16_t *Q, *Kb, *V, *GV, *SA; float* kmean; const float *qg, *kg;
    __device__ __forceinline__ void first(const Unit&, const EpiCtx&) const {}
    __device__ __forceinline__ void operator()(const f32x4 (&acc)[2][2][4][2], const Unit& u, int wr, int wc, int fr, int fq, const EpiCtx& X) const {
        const int pn = u.pn; const int row0 = u.pm * BM + wr * 64 + fr;
        if (pn < 4) {
            const bool isk = pn >= 2; const int head = (pn & 1) * 4 + wc;
            const float* gp = (isk ? kg : qg) + 8 * fq; const float sc = isk ? 1.0f : QC2;
            f32x4 g[2][2];
#pragma unroll
            for (int bj = 0; bj < 2; ++bj)
#pragma unroll
                for (int n = 0; n < 2; ++n) g[bj][n] = *(const f32x4*)(gp + bj * 32 + 4 * n) * sc;
            bf16_t* base = (isk ? Kb : Q) + head * 64 + 8 * fq;
            f32x4 cs[2][2];
#pragma unroll
            for (int bj = 0; bj < 2; ++bj)
#pragma unroll
                for (int n = 0; n < 2; ++n) cs[bj][n] = (f32x4){0.f, 0.f, 0.f, 0.f};
#pragma unroll
            for (int ai = 0; ai < 2; ++ai)
#pragma unroll
                for (int m = 0; m < 4; ++m) {
                    float ss = 0.f;
#pragma unroll
                    for (int bj = 0; bj < 2; ++bj)
#pragma unroll
                        for (int n = 0; n < 2; ++n) { const f32x4 x = acc[ai][bj][m][n]; ss += (x[0] * x[0] + x[1] * x[1]) + (x[2] * x[2] + x[3] * x[3]); }
                    ss += __shfl_xor(ss, 16); ss += __shfl_xor(ss, 32);
                    const float rstd = rsqrtf(ss * (1.0f / 64.0f) + RMS_EPS);
                    bf16_t* rowp = base + (size_t)(row0 + ai * HALF + m * 16) * 512;
#pragma unroll
                    for (int bj = 0; bj < 2; ++bj) { const f32x4 v0 = acc[ai][bj][m][0] * rstd * g[bj][0], v1 = acc[ai][bj][m][1] * rstd * g[bj][1];
                        cs[bj][0] += v0; cs[bj][1] += v1; *(u32x4*)(rowp + bj * 32) = pack8(v0, v1); }
                }
            if (isk) {
                float* km = kmean + ((size_t)u.pm * 8 + head) * 64 + 8 * fq;
#pragma unroll
                for (int bj = 0; bj < 2; ++bj)
#pragma unroll
                    for (int n = 0; n < 2; ++n)
#pragma unroll
                        for (int e = 0; e < 4; ++e) { float v = cs[bj][n][e]; v += __shfl_xor(v, 1); v += __shfl_xor(v, 2); v += __shfl_xor(v, 4); v += __shfl_xor(v, 8);
                            if (fr == 0) atomicAdd(km + bj * 32 + 4 * n + e, v * (1.0f / 256.0f)); }
            }
        } else {
            bf16_t* base; int pitch, t, act;
            if (pn < 10) { const int grp = (pn - 4) >> 1; base = V + (size_t)grp * (16u << 20); pitch = 512; t = (pn - 4) & 1; act = 0; }
            else if (pn < 18) { const int grp = (pn - 10) >> 2; base = GV + (size_t)grp * (32u << 20); pitch = 1024; t = (pn - 10) & 3; act = grp; }
            else { const int grp = (pn - 18) >> 2; base = SA + (size_t)grp * ((size_t)32768 * 1024); pitch = 1024; t = (pn - 18) & 3; act = 2; }
            bf16_t* tile0 = base + (size_t)(u.pm * BM) * pitch + t * BM;
            int it = 0;
#pragma unroll
            for (int ai = 0; ai < 2; ++ai)
#pragma unroll
                for (int m = 0; m < 4; ++m)
#pragma unroll
                    for (int bj = 0; bj < 2; ++bj) { f32x4 v0 = acc[ai][bj][m][0], v1 = acc[ai][bj][m][1];
                        if (act != 0) {
#pragma unroll
                            for (int e = 0; e < 4; ++e) { const float s0 = sigm(v0[e]), s1 = sigm(v1[e]); v0[e] = (act == 1) ? v0[e] * s0 : s0; v1[e] = (act == 1) ? v1[e] * s1 : s1; } }
                        stage_store(pack8(v0, v1), it++, X.stg, wr, wc, fr, fq, tile0 + (size_t)(ai * HALF + m * 16) * pitch + bj * HALF, pitch); }
        }
    }
};
template <bool ADD> struct EpiMix {
    static constexpr bool PERM = true, AFTER_DRAIN = false, HAS_MID = ADD;
    const bf16_t* S; bf16_t* MIX; const float* ssq2;
    __device__ __forceinline__ void fill_table(int pm, PG8_LAS float* tab) const {
        const int row = threadIdx.x >> 1, half = threadIdx.x & 1; float s2[2];
#pragma unroll
        for (int hh = 0; hh < 2; ++hh) { const f32x4* sp = (const f32x4*)(ssq2 + ((size_t)(pm * BM + row) * 4 + 2 * half + hh) * 16);
            const f32x4 t = (sp[0] + sp[1]) + (sp[2] + sp[3]); s2[hh] = rsqrtf(((t[0] + t[1]) + (t[2] + t[3])) * (1.0f / 256.0f) + RMS_EPS); }
        const float pa = __shfl_xor(s2[0], 1), pb = __shfl_xor(s2[1], 1);
        if (half == 0) { tab[256 + row] = s2[0] * __builtin_amdgcn_rcpf(s2[1]); tab[512 + row] = s2[1] * __builtin_amdgcn_rcpf(pa); }
        else { tab[768 + row] = s2[0] * __builtin_amdgcn_rcpf(s2[1]); tab[row] = s2[1]; }
        (void)pb;
    }
    __device__ __forceinline__ void first(const Unit& u, const EpiCtx& X) const { if (ADD) fill_table(u.pm, (PG8_LAS float*)(X.stg + 17408)); }
    __device__ __forceinline__ bool mid_at(int t) const { return t == 4 || t == 8 || t == 12; }
    __device__ __forceinline__ void mid(f32x4 (&acc)[2][2][4][2], const Unit& u, int wr, int wc, int fr, int fq, const EpiCtx& X, int t) const {
        const PG8_LAS float* tab = (const PG8_LAS float*)(X.stg + 17408 + 4096 * (X.ui & 1)) + (t >> 2) * 256;
#pragma unroll
        for (int ai = 0; ai < 2; ++ai)
#pragma unroll
            for (int m = 0; m < 4; ++m) { const float r = tab[ai * HALF + wr * 64 + m * 16 + fr];
#pragma unroll
                for (int bj = 0; bj < 2; ++bj)
#pragma unroll
                    for (int n = 0; n < 2; ++n) acc[ai][bj][m][n] = acc[ai][bj][m][n] * r; }
    }
    __device__ __forceinline__ void operator()(const f32x4 (&acc)[2][2][4][2], const Unit& u, int wr, int wc, int fr, int fq, const EpiCtx& X) const {
        const int row0 = u.pm * BM + wr * 64 + fr, col0 = u.pn * BM + wc * 32 + 8 * fq;
        const PG8_LAS float* tab = (const PG8_LAS float*)(X.stg + 17408 + 4096 * (X.ui & 1));
#pragma unroll
        for (int ai = 0; ai < 2; ++ai) {
            u32x4 sv[4][2], pv[4][2];
#pragma unroll
            for (int m = 0; m < 4; ++m) { const size_t off = (size_t)(row0 + ai * HALF + m * 16) * 1024 + col0;
#pragma unroll
                for (int bj = 0; bj < 2; ++bj) { sv[m][bj] = *(const u32x4*)(S + off + bj * HALF); if (ADD) pv[m][bj] = *(const u32x4*)(MIX + off + bj * HALF); } }
#pragma unroll
            for (int m = 0; m < 4; ++m) { const size_t off = (size_t)(row0 + ai * HALF + m * 16) * 1024 + col0; const float s3 = ADD ? tab[ai * HALF + wr * 64 + m * 16 + fr] : 1.0f;
#pragma unroll
                for (int bj = 0; bj < 2; ++bj) { const u32x4 s = sv[m][bj];
                    f32x4 v0 = acc[ai][bj][m][0] * s3 * (f32x4){bflo(s.x), bfhi(s.x), bflo(s.y), bfhi(s.y)}, v1 = acc[ai][bj][m][1] * s3 * (f32x4){bflo(s.z), bfhi(s.z), bflo(s.w), bfhi(s.w)};
                    if (ADD) { const u32x4 p = pv[m][bj]; v0 += (f32x4){bflo(p.x), bfhi(p.x), bflo(p.y), bfhi(p.y)}; v1 += (f32x4){bflo(p.z), bfhi(p.z), bflo(p.w), bfhi(p.w)}; }
                    *(u32x4*)(MIX + off + bj * HALF) = pack8(v0, v1); } } }
        if (ADD && X.has_next) fill_table(X.nxt.pm, (PG8_LAS float*)(X.stg + 17408 + 4096 * ((X.ui + 1) & 1)));
    }
};
struct EpiWout {
    static constexpr bool PERM = true, AFTER_DRAIN = false, HAS_MID = false;
    const float* x; float* out; bf16_t* H1B; float* ssq;
    __device__ __forceinline__ void first(const Unit&, const EpiCtx&) const {}
    __device__ __forceinline__ void operator()(const f32x4 (&acc)[2][2][4][2], const Unit& u, int wr, int wc, int fr, int fq, const EpiCtx& X) const {
        const int row0 = u.pm * BM + wr * 64 + fr, col0 = u.pn * BM + wc * 32 + 8 * fq;
#pragma unroll
        for (int ai = 0; ai < 2; ++ai) {
            f32x4 xv[4][2][2];
#pragma unroll
            for (int m = 0; m < 4; ++m) { const size_t off = (size_t)(row0 + ai * HALF + m * 16) * 1024 + col0;
#pragma unroll
                for (int bj = 0; bj < 2; ++bj) { xv[m][bj][0] = *(const f32x4*)(x + off + bj * HALF); xv[m][bj][1] = *(const f32x4*)(x + off + bj * HALF + 4); } }
#pragma unroll
            for (int m = 0; m < 4; ++m) { const int row = row0 + ai * HALF + m * 16; const size_t off = (size_t)row * 1024 + col0; float ss = 0.f;
#pragma unroll
                for (int bj = 0; bj < 2; ++bj) { const f32x4 h0 = xv[m][bj][0] + acc[ai][bj][m][0], h1 = xv[m][bj][1] + acc[ai][bj][m][1];
                    *(u32x4*)(H1B + off + bj * HALF) = pack8(h0, h1);
                    ss += (h0[0] * h0[0] + h0[1] * h0[1]) + (h0[2] * h0[2] + h0[3] * h0[3]) + (h1[0] * h1[0] + h1[1] * h1[1]) + (h1[2] * h1[2] + h1[3] * h1[3]); }
                ss += __shfl_xor(ss, 16); ss += __shfl_xor(ss, 32);
                if (fq == 0) ssq[(size_t)row * 16 + u.pn * 4 + wc] = ss; } }
    }
};
struct EpiUp {
    static constexpr bool PERM = true, AFTER_DRAIN = false, HAS_MID = false;
    const float* ssq; bf16_t* HB;
    __device__ __forceinline__ void table(const Unit& u, PG8_LAS float* tab, const f32x4& a, const f32x4& b) const {
        const f32x4 t = a + b; float s = (t[0] + t[1]) + (t[2] + t[3]); s += __shfl_xor(s, 1);
        if ((threadIdx.x & 1) == 0) tab[threadIdx.x >> 1] = rsqrtf(s * (1.0f / 1024.0f) + RMS_EPS);
    }
    __device__ __forceinline__ void first(const Unit& u, const EpiCtx& X) const {
        const f32x4* sp = (const f32x4*)(ssq + (size_t)(u.pm * BM + (threadIdx.x >> 1)) * 16 + (threadIdx.x & 1) * 8);
        table(u, (PG8_LAS float*)(X.stg + 17408), sp[0], sp[1]);
    }
    __device__ __forceinline__ void operator()(const f32x4 (&acc)[2][2][4][2], const Unit& u, int wr, int wc, int fr, int fq, const EpiCtx& X) const {
        f32x4 na = (f32x4){0.f, 0.f, 0.f, 0.f}, nb = na;
        if (X.has_next) { const f32x4* sp = (const f32x4*)(ssq + (size_t)(X.nxt.pm * BM + (threadIdx.x >> 1)) * 16 + (threadIdx.x & 1) * 8); na = sp[0]; nb = sp[1]; }
        const PG8_LAS float* tab = (const PG8_LAS float*)(X.stg + 17408 + 1024 * (X.ui & 1));
        bf16_t* tile0 = HB + (size_t)(u.pm * BM) * 4096 + u.pn * BM;
        int it = 0;
#pragma unroll
        for (int ai = 0; ai < 2; ++ai)
#pragma unroll
            for (int m = 0; m < 4; ++m) { const float rstd = tab[ai * HALF + wr * 64 + m * 16 + fr];
#pragma unroll
                for (int bj = 0; bj < 2; ++bj) { f32x4 v0 = acc[ai][bj][m][0] * rstd, v1 = acc[ai][bj][m][1] * rstd;
#pragma unroll
                    for (int e = 0; e < 4; ++e) { const float r0 = fmaxf(v0[e], 0.f), r1 = fmaxf(v1[e], 0.f); v0[e] = r0 * r0; v1[e] = r1 * r1; }
                    stage_store(pack8(v0, v1), it++, X.stg, wr, wc, fr, fq, tile0 + (size_t)(ai * HALF + m * 16) * 4096 + bj * HALF, 4096); } }
        if (X.has_next) table(X.nxt, (PG8_LAS float*)(X.stg + 17408 + 1024 * ((X.ui + 1) & 1)), na, nb);
    }
};
struct EpiDown {
    static constexpr bool PERM = false, AFTER_DRAIN = false, HAS_MID = false;
    const bf16_t* in; float* out;
    __device__ __forceinline__ void first(const Unit&, const EpiCtx&) const {}
    __device__ __forceinline__ void operator()(const f32x4 (&acc)[2][2][4][2], const Unit& u, int wr, int wc, int fr, int fq, const EpiCtx& X) const {
        typedef unsigned u32x2 __attribute__((ext_vector_type(2)));
        const int row0 = u.pm * BM + wr * 64 + fr, col0 = u.pn * BM + wc * 32 + 4 * fq;
        u32x2 h[2][4][2][2];
#pragma unroll
        for (int ai = 0; ai < 2; ++ai)
#pragma unroll
            for (int m = 0; m < 4; ++m) { const size_t ro = (size_t)(row0 + ai * HALF + m * 16) * 1024 + col0;
#pragma unroll
                for (int bj = 0; bj < 2; ++bj)
#pragma unroll
                    for (int n = 0; n < 2; ++n) h[ai][m][bj][n] = *(const u32x2*)(in + ro + bj * HALF + n * 16); }
#pragma unroll
        for (int ai = 0; ai < 2; ++ai)
#pragma unroll
            for (int m = 0; m < 4; ++m) { const size_t ro = (size_t)(row0 + ai * HALF + m * 16) * 1024 + col0;
#pragma unroll
                for (int bj = 0; bj < 2; ++bj)
#pragma unroll
                    for (int n = 0; n < 2; ++n) { const u32x2 hh = h[ai][m][bj][n];
                        *(f32x4*)(out + ro + bj * HALF + n * 16) = (f32x4){bflo(hh.x), bfhi(hh.x), bflo(hh.y), bfhi(hh.y)} + acc[ai][bj][m][n]; } }
    }
};

template <class Epi, class Sched, bool ALIGN_EPI = false, bool SP2 = false>
__device__ __forceinline__ void gemm_phase(PG8_LAS unsigned char* lds, const Gemm g, const Sched& S, const Epi& E) {
    const int tid = threadIdx.x, wid = __builtin_amdgcn_readfirstlane(tid >> 6), lane = tid & 63, wr = wid >> 2, wc = wid & 3, fr = lane & 15, fq = lane >> 4;
    const int K = g.K, nt = K / BK;
    unsigned voffA[2], voffB[2];
#pragma unroll
    for (int i = 0; i < 2; ++i) { int R, C; stage_rc(tid * 16 + i * 8192, R, C); const int Rb = Epi::PERM ? ((R & ~31) + perm32(R & 31)) : R;
        voffA[i] = (unsigned)(R * K + C) * 2u; voffB[i] = (unsigned)(Rb * K + C) * 2u; }
    const size_t kstep = (size_t)(BK * 2);
    const size_t hstep = (size_t)HALF * K * 2;
    const size_t tstep = 2 * hstep;
    const unsigned ldsw = (unsigned)wid * 1024u;
    const int aoff = lds_byte(wr * 64 + fr, fq * 8), boff = lds_byte(wc * 32 + fr, fq * 8);
#define PG8_SA(b, h) (((b) * 2 + (h)) * HTB)
#define PG8_SB(b, h) ((4 + (b) * 2 + (h)) * HTB)
#define PG8_STAGE(bufoff, gbase, voff) do { _Pragma("unroll") for (int _i = 0; _i < 2; ++_i) \
        __builtin_amdgcn_global_load_lds((const unsigned*)((const char*)(gbase) + (voff)[_i]), (PG8_LAS unsigned*)(lds + (bufoff) + ldsw + _i * 8192), 16, 0, 0); } while (0)
#define PG8_LDA(dst, b, h) do { _Pragma("unroll") for (int m = 0; m < 4; ++m) _Pragma("unroll") for (int k = 0; k < 2; ++k) dst[m][k] = *(const PG8_LAS bf16x8*)(lds + PG8_SA(b, h) + aoff + m * 2048 + k * 1024); } while (0)
#define PG8_LDB(dst, b, h) do { _Pragma("unroll") for (int n = 0; n < 2; ++n) _Pragma("unroll") for (int k = 0; k < 2; ++k) dst[n][k] = *(const PG8_LAS bf16x8*)(lds + PG8_SB(b, h) + boff + n * 2048 + k * 1024); } while (0)
#define PG8_MMA(ai, bj, At, Bt) do { __builtin_amdgcn_s_setprio(1); _Pragma("unroll") for (int m = 0; m < 4; ++m) _Pragma("unroll") for (int n = 0; n < 2; ++n) _Pragma("unroll") for (int k = 0; k < 2; ++k) \
        acc[ai][bj][m][n] = __builtin_amdgcn_mfma_f32_16x16x32_bf16(Bt[n][k], At[m][k], acc[ai][bj][m][n], 0, 0, 0); __builtin_amdgcn_s_setprio(0); } while (0)
#define PG8_WAIT_V(n) asm volatile("s_waitcnt vmcnt(" #n ")" ::: "memory")
#define PG8_WAIT_L(n) asm volatile("s_waitcnt lgkmcnt(" #n ")" ::: "memory")
#define PG8_BAR __builtin_amdgcn_s_barrier()
#define PG8_SCHED __builtin_amdgcn_sched_barrier(0)
    Unit cur, nxt; int ui = 0;
    if (!S.next(0, cur)) return;
    f32x4 acc[2][2][4][2];
#pragma unroll
    for (int a = 0; a < 2; ++a)
#pragma unroll
        for (int b = 0; b < 2; ++b)
#pragma unroll
            for (int m = 0; m < 4; ++m)
#pragma unroll
                for (int n = 0; n < 2; ++n) acc[a][b][m][n] = (f32x4){0.f, 0.f, 0.f, 0.f};
    bf16x8 At[4][2], B0[2][2], B1[2][2];
    const char* cA = (const char*)g.A + (size_t)cur.pm * tstep; const char* cB = (const char*)g.Bt + (size_t)cur.pn * tstep;
    S.a_ready(cur);
    EpiCtx X; X.stg = lds + STAGE_BYTES; X.ui = 0; X.has_next = false; X.nxt = cur;
    E.first(cur, X);
    if constexpr (SP2) {
        PG8_STAGE(PG8_SB(0, 0), cB, voffB); PG8_STAGE(PG8_SB(0, 1), cB + hstep, voffB); PG8_STAGE(PG8_SA(0, 0), cA, voffA); PG8_STAGE(PG8_SA(0, 1), cA + hstep, voffA);
        if (wr == 1) PG8_BAR;
        PG8_WAIT_V(2); PG8_BAR;
        PG8_STAGE(PG8_SB(1, 0), cB + kstep, voffB); PG8_STAGE(PG8_SA(1, 0), cA + kstep, voffA); PG8_STAGE(PG8_SB(1, 1), cB + hstep + kstep, voffB);
        PG8_WAIT_V(6); PG8_BAR;
    } else {
        PG8_STAGE(PG8_SB(0, 0), cB, voffB); PG8_STAGE(PG8_SA(0, 0), cA, voffA); PG8_STAGE(PG8_SB(0, 1), cB + hstep, voffB); PG8_STAGE(PG8_SA(0, 1), cA + hstep, voffA);
        if (wr == 1) PG8_BAR;
        PG8_WAIT_V(4); PG8_BAR;
        PG8_STAGE(PG8_SB(1, 0), cB + kstep, voffB); PG8_STAGE(PG8_SA(1, 0), cA + kstep, voffA); PG8_STAGE(PG8_SB(1, 1), cB + hstep + kstep, voffB);
        PG8_WAIT_V(6); PG8_BAR;
    }
    for (;;) {
        const bool has_next = S.next(ui + 1, nxt);
        const char* nA = has_next ? (const char*)g.A + (size_t)nxt.pm * tstep : cA; const char* nB = has_next ? (const char*)g.Bt + (size_t)nxt.pn * tstep : cB;
        X.ui = ui;
        for (int t = 0; t < nt; t += 2) {
            if constexpr (Epi::HAS_MID) { if (E.mid_at(t)) E.mid(acc, cur, wr, wc, fr, fq, X, t); }
            const bool last = (t == nt - 2);
            const char* a1 = cA + (size_t)(t + 1) * kstep;
            const char* a2 = last ? nA : cA + (size_t)(t + 2) * kstep; const char* b2 = last ? nB : cB + (size_t)(t + 2) * kstep;
            const char* a3 = a2 + kstep; const char* b3 = b2 + kstep;
            if (last && has_next) S.a_ready(nxt);
            if constexpr (SP2) {
            PG8_LDB(B0, 0, 0); PG8_LDB(B1, 0, 1); PG8_SCHED; PG8_LDA(At, 0, 0); PG8_STAGE(PG8_SA(1, 1), a1 + hstep, voffA);
            PG8_WAIT_V(8); PG8_WAIT_L(0); PG8_BAR; PG8_MMA(0, 0, At, B0); PG8_MMA(0, 1, At, B1); PG8_BAR; PG8_SCHED;
            PG8_LDA(At, 0, 1); PG8_STAGE(PG8_SB(0, 0), b2, voffB); PG8_STAGE(PG8_SB(0, 1), b2 + hstep, voffB); PG8_STAGE(PG8_SA(0, 0), a2, voffA);
            PG8_WAIT_V(8); PG8_WAIT_L(0); PG8_BAR; PG8_MMA(1, 0, At, B0); PG8_MMA(1, 1, At, B1); PG8_BAR; PG8_SCHED;
            PG8_LDB(B0, 1, 0); PG8_LDB(B1, 1, 1); PG8_SCHED; PG8_LDA(At, 1, 0); PG8_STAGE(PG8_SA(0, 1), a2 + hstep, voffA);
            PG8_WAIT_V(8); PG8_WAIT_L(0); PG8_BAR; PG8_MMA(0, 0, At, B0); PG8_MMA(0, 1, At, B1); PG8_BAR; PG8_SCHED;
            PG8_LDA(At, 1, 1); PG8_STAGE(PG8_SB(1, 0), b3, voffB); PG8_STAGE(PG8_SB(1, 1), b3 + hstep, voffB); PG8_STAGE(PG8_SA(1, 0), a3, voffA);
            PG8_WAIT_V(8); PG8_WAIT_L(0); PG8_BAR; PG8_MMA(1, 0, At, B0); PG8_MMA(1, 1, At, B1); PG8_BAR; PG8_SCHED;
            } else {
            PG8_LDB(B0, 0, 0); PG8_SCHED; PG8_LDA(At, 0, 0); PG8_STAGE(PG8_SA(1, 1), a1 + hstep, voffA);
            PG8_WAIT_L(8); PG8_BAR; PG8_WAIT_L(0); PG8_MMA(0, 0, At, B0); PG8_BAR; PG8_SCHED;
            PG8_LDB(B1, 0, 1); PG8_STAGE(PG8_SB(0, 0), b2, voffB);
            PG8_BAR; PG8_WAIT_L(0); PG8_MMA(0, 1, At, B1); PG8_BAR;
            PG8_LDA(At, 0, 1); PG8_STAGE(PG8_SA(0, 0), a2, voffA);
            PG8_BAR; PG8_WAIT_L(0); PG8_MMA(1, 0, At, B0); PG8_BAR; PG8_SCHED;
            PG8_STAGE(PG8_SB(0, 1), b2 + hstep, voffB);
            PG8_WAIT_V(6); PG8_BAR; PG8_MMA(1, 1, At, B1); PG8_BAR;
            PG8_LDB(B0, 1, 0); PG8_SCHED; PG8_LDA(At, 1, 0); PG8_STAGE(PG8_SA(0, 1), a2 + hstep, voffA);
            PG8_WAIT_L(8); PG8_BAR; PG8_WAIT_L(0); PG8_MMA(0, 0, At, B0); PG8_BAR; PG8_SCHED;
            PG8_LDB(B1, 1, 1); PG8_STAGE(PG8_SB(1, 0), b3, voffB);
            PG8_BAR; PG8_WAIT_L(0); PG8_MMA(0, 1, At, B1); PG8_BAR;
            PG8_LDA(At, 1, 1); PG8_STAGE(PG8_SA(1, 0), a3, voffA);
            PG8_BAR; PG8_WAIT_L(0); PG8_MMA(1, 0, At, B0); PG8_BAR; PG8_SCHED;
            PG8_STAGE(PG8_SB(1, 1), b3 + hstep, voffB);
            PG8_WAIT_V(6); PG8_BAR; PG8_MMA(1, 1, At, B1); PG8_BAR;
            }
        }
        if constexpr (ALIGN_EPI) { if (wr == 0) PG8_BAR; }
        if constexpr (!Epi::AFTER_DRAIN) { X.ui = ui; X.has_next = has_next; X.nxt = nxt; E(acc, cur, wr, wc, fr, fq, X); S.done(cur); }
        if (!has_next) break;
#pragma unroll
        for (int a = 0; a < 2; ++a)
#pragma unroll
            for (int b = 0; b < 2; ++b)
#pragma unroll
                for (int m = 0; m < 4; ++m)
#pragma unroll
                    for (int n = 0; n < 2; ++n) acc[a][b][m][n] = (f32x4){0.f, 0.f, 0.f, 0.f};
        cur = nxt; cA = nA; cB = nB; ++ui;
        if constexpr (ALIGN_EPI) { if (wr == 1) PG8_BAR; }
    }
    PG8_WAIT_V(0);
    if constexpr (!ALIGN_EPI) { if (wr == 0) PG8_BAR; }
    PG8_BAR;
    if constexpr (Epi::AFTER_DRAIN) { E.fused(acc, cur, wr, wc, fr, fq, lds, wid, lane); S.done(cur); }
#undef PG8_SA
#undef PG8_SB
#undef PG8_STAGE
#undef PG8_LDA
#undef PG8_LDB
#undef PG8_MMA
#undef PG8_WAIT_V
#undef PG8_WAIT_L
#undef PG8_BAR
#undef PG8_SCHED
}
}
constexpr int NWAVES = 8;
constexpr int BATCH = 8, SEQ = 4096, DMODEL = 1024, FF = 4096, M = BATCH * SEQ;
constexpr int D_IN = 6672, NPROJ = 6656;
constexpr int GLOW_COL = 3584;
#ifndef MK_N_LAUNCHES
#define MK_N_LAUNCHES 1
#endif
constexpr int N_PHASES = 8;
constexpr int N_LAUNCHES = MK_N_LAUNCHES;

constexpr size_t MiB = 1u << 20;
constexpr size_t WS_CTL = 0, WS_KMEAN = 1 * MiB, CTL_ZERO_BYTES = 2 * MiB;
constexpr size_t WS_SSQ = 2 * MiB, WS_GLOW = 4 * MiB, WS_GAM = 42 * MiB;
constexpr size_t WS_WIN = 6 * MiB, WS_WGL = 19 * MiB, WS_WBA = 20 * MiB, WS_WBG = 21 * MiB, WS_WOUT = 23 * MiB, WS_WUP = 25 * MiB, WS_WDN = 33 * MiB;
constexpr size_t WS_ST = 44 * MiB, WS_XN = 44 * MiB, WS_MIX = 44 * MiB;
constexpr size_t WS_Q = 172 * MiB, WS_K = 204 * MiB, WS_V = 236 * MiB, WS_GQ = 268 * MiB, WS_GK = 300 * MiB;
constexpr size_t WS_GV = 332 * MiB, WS_H1B = 332 * MiB;
constexpr size_t WS_GO = 396 * MiB;
constexpr size_t WS_HB = 44 * MiB;
constexpr size_t WS_SSQ2 = 460 * MiB;
constexpr size_t WS_END = 468 * MiB;
constexpr int CW_TMO = 0, CW_CODE = 1, CW_QUEUE = 1024, CW_BAR = 4096;

constexpr int RING_OFF = 0, RING_BYTES = 143360;
constexpr int LDSCTL_OFF = 163840 - 512, MISC_OFF = LDSCTL_OFF + 320;
constexpr int LDS_BYTES = 163840;
#define GAS __attribute__((address_space(1)))
#define LAS __attribute__((address_space(3)))
typedef unsigned short bf16;
typedef unsigned v4u __attribute__((ext_vector_type(4)));
typedef float f32x4 __attribute__((ext_vector_type(4)));
typedef short bf16x8 __attribute__((ext_vector_type(8)));
typedef GAS unsigned gu32;
typedef GAS unsigned long long gu64;
#define RLX_AGENT __ATOMIC_RELAXED, __HIP_MEMORY_SCOPE_AGENT
#define LDS_WAIT() asm volatile("s_waitcnt lgkmcnt(0)" ::: "memory")
#define VM_WAIT() asm volatile("s_waitcnt vmcnt(0)" ::: "memory")
__device__ __forceinline__ unsigned long long rt() { return __builtin_amdgcn_s_memrealtime(); }
__device__ __forceinline__ unsigned pk2(float lo, float hi) { typedef float f32x2_t __attribute__((ext_vector_type(2))); typedef __bf16 bf16x2_t __attribute__((ext_vector_type(2)));
    f32x2_t v = {lo, hi}; bf16x2_t b = __builtin_convertvector(v, bf16x2_t); return __builtin_bit_cast(unsigned, b); }
__device__ __forceinline__ unsigned f2bf(float f) { return pk2(f, 0.f) & 0xffffu; }
#define XB_TMO      128
#define XB_XCNT(j)  (256  + 64 * (j))
#define XB_XSUB(j)  (1280 + 64 * (j))
#define XB_XGEN(j)  (2304 + 64 * (j))
#define XB_TOP      3328
#define XB_TOPGEN   3392
#define XCD_BAR_WORDS 3456
#define XB_SPIN_CAP (1u << 18)

__device__ __forceinline__ unsigned xb_ld(unsigned* p)              { return __hip_atomic_load(p, __ATOMIC_RELAXED, __HIP_MEMORY_SCOPE_AGENT); }
__device__ __forceinline__ unsigned xb_add(unsigned* p, unsigned v) { return __hip_atomic_fetch_add(p, v, __ATOMIC_RELAXED, __HIP_MEMORY_SCOPE_AGENT); }
__device__ __forceinline__ unsigned xb_xcc_id() { return (unsigned)__builtin_amdgcn_s_getreg((3 << 11) | 20) & 0xFu; }
#define XB_SPIN(cond, bar) do { unsigned _sp = 0; while (cond) { __builtin_amdgcn_s_sleep(1); \
    if ((++_sp & 255u) == 0u) { if (xb_ld(&(bar)[XB_TMO])) break; if (_sp > XB_SPIN_CAP) { atomicAdd(&(bar)[XB_TMO], 1u); break; } } } } while (0)

struct XcdBarrier {
    unsigned* bar; unsigned x;
    volatile LAS unsigned* st;
};

__device__ __forceinline__ XcdBarrier xcd_barrier_post(unsigned* bar, volatile LAS unsigned* st) {
    XcdBarrier b; b.bar = bar; b.x = xb_xcc_id(); b.st = st;
    if (threadIdx.x == 0) (void)xb_add(&bar[XB_XCNT(b.x)], 1u);
    return b;
}
__device__ __forceinline__ void xcd_barrier_complete(unsigned* bar, unsigned x, unsigned& nloc, unsigned& nx) {
    const unsigned G = gridDim.x * gridDim.y * gridDim.z;
    unsigned sum, cnt, mine, sp = 0u;
    for (;;) {
        sum = 0u; cnt = 0u; mine = 0u;
#pragma unroll
        for (unsigned j = 0; j < 16; ++j) { const unsigned c = xb_ld(&bar[XB_XCNT(j)]); sum += c; cnt += (c > 0u) ? 1u : 0u; mine = (j == x) ? c : mine; }
        if (sum == G) break;
        __builtin_amdgcn_s_sleep(1);
        if ((++sp & 255u) == 0u) { if (xb_ld(&bar[XB_TMO])) break; if (sp > XB_SPIN_CAP) { atomicAdd(&bar[XB_TMO], 1u); break; } }
    }
    nloc = mine > 0u ? mine : 1u; nx = cnt > 0u ? cnt : 1u;
}

__device__ __forceinline__ void xcd_barrier(const XcdBarrier& b) {
    asm volatile("s_waitcnt vmcnt(0)" ::: "memory");
    __syncthreads();
    if (threadIdx.x == 0) {
        unsigned* bar = b.bar;
        __builtin_amdgcn_s_waitcnt(0);
        unsigned nloc = b.st[0], nx = b.st[1];
        if (nloc == 0u) { xcd_barrier_complete(bar, b.x, nloc, nx); b.st[0] = nloc; b.st[1] = nx; }
        const unsigned old = xb_add(&bar[XB_XSUB(b.x)], 1u);
        const unsigned gen = old / nloc;
        if (old + 1u == (gen + 1u) * nloc) {
            __builtin_amdgcn_fence(__ATOMIC_RELEASE, "agent");
            asm volatile("s_waitcnt vmcnt(0)" ::: "memory");
            const unsigned og = xb_add(&bar[XB_TOP], 1u);
            const unsigned tg = og / nx;
            if (og + 1u == (tg + 1u) * nx) xb_add(&bar[XB_TOPGEN], 1u);
            else XB_SPIN(xb_ld(&bar[XB_TOPGEN]) == tg, bar);
            __builtin_amdgcn_fence(__ATOMIC_ACQUIRE, "agent");
            xb_add(&bar[XB_XGEN(b.x)], 1u);
            asm volatile("s_waitcnt vmcnt(0)" ::: "memory");
        } else {
            XB_SPIN(xb_ld(&bar[XB_XGEN(b.x)]) == gen, bar);
            __builtin_amdgcn_fence(__ATOMIC_ACQUIRE, "agent");
            asm volatile("s_waitcnt vmcnt(0)" ::: "memory");
        }
    }
    __syncthreads();
}
struct Frame {
    LAS unsigned char* lds;
    volatile LAS unsigned* MISC;
    gu32* ctl;
    int tid, lane, wave;
    int vcu, G;
};
__device__ __forceinline__ float wave_sum(float v) {
#pragma unroll
    for (int o = 1; o < 64; o <<= 1) v += __shfl_xor(v, o);
    return v;
}
__device__ __forceinline__ void p0_item(const float* W, int ldw, int scol, int k0, bf16* WT, int K, int drow, const float* ks, LAS float* scr, int lane) {
#pragma unroll 8
    for (int i = 0; i < 32; ++i) { const int kk = 2 * i + (lane >> 5); float v = W[(size_t)(k0 + kk) * ldw + scol + (lane & 31)]; if (ks) v *= ks[k0 + kk]; scr[kk * 33 + (lane & 31)] = v; }
    LDS_WAIT(); asm volatile("" ::: "memory");
    const int c = lane & 7;
#pragma unroll
    for (int j = 0; j < 4; ++j) { const int n = (lane >> 3) + 8 * j; const LAS float* s = scr + (8 * c) * 33 + n;
        v4u o; o.x = pk2(s[0 * 33], s[1 * 33]); o.y = pk2(s[2 * 33], s[3 * 33]); o.z = pk2(s[4 * 33], s[5 * 33]); o.w = pk2(s[6 * 33], s[7 * 33]);
        *(GAS v4u*)(WT + (size_t)(drow + n) * K + k0 + 8 * c) = o; }
    LDS_WAIT(); asm volatile("" ::: "memory");
}
__device__ __forceinline__ void p0_item128(const float* W, int ldw, int scol, int k0, bf16* WT, int K, int drow, const float* ks, LAS float* scr, int lane) {
    float v[64];
#pragma unroll
    for (int i = 0; i < 64; ++i) { const int kk = 2 * i + (lane >> 5); v[i] = W[(size_t)(k0 + kk) * ldw + scol + (lane & 31)]; }
    if (ks) {
#pragma unroll
        for (int i = 0; i < 64; ++i) v[i] *= ks[k0 + 2 * i + (lane >> 5)]; }
#pragma unroll
    for (int i = 0; i < 64; ++i) scr[(2 * i + (lane >> 5)) * 33 + (lane & 31)] = v[i];
    LDS_WAIT(); asm volatile("" ::: "memory");
    const int c = lane & 7;
#pragma unroll
    for (int kc = 0; kc < 2; ++kc)
#pragma unroll
        for (int j = 0; j < 4; ++j) { const int n = (lane >> 3) + 8 * j; const LAS float* s = scr + (64 * kc + 8 * c) * 33 + n;
            v4u o; o.x = pk2(s[0 * 33], s[1 * 33]); o.y = pk2(s[2 * 33], s[3 * 33]); o.z = pk2(s[4 * 33], s[5 * 33]); o.w = pk2(s[6 * 33], s[7 * 33]);
            *(GAS v4u*)(WT + (size_t)(drow + n) * K + k0 + 64 * kc + 8 * c) = o; }
    LDS_WAIT(); asm volatile("" ::: "memory");
}
__device__ __forceinline__ int win_src_col(int n0) {
    const int tile = n0 >> 8, pt = n0 & 255;
    int lc = (tile < 4) ? (64 * ((pt >> 5) & 3) + 32 * (pt >> 7)) : pt;
    lc += 256 * tile; return lc >= GLOW_COL ? lc + 16 : lc;
}
struct Ptrs {
    const float *x, *g1, *w_in, *qg, *kg, *t5, *gup, *gbias, *gnorm, *wba, *wbg, *wout, *g2, *wup, *wdn;
    float* out; unsigned char* ws;
};
constexpr int P0_I_IN = 16 * (NPROJ / 32), P0_NITEMS = P0_I_IN + 8 * 32 + 16 * 32 + 16 * 32 + 16 * 128 + 64 * 32;
__device__ __forceinline__ void p0_prologue(Frame& F, const Ptrs& P) {
    LAS float* scr = (LAS float*)(F.lds + RING_OFF + F.wave * 16384);
    const int gw = F.vcu * NWAVES + F.wave, NGW = F.G * NWAVES;
    bf16* WIN = (bf16*)(P.ws + WS_WIN); bf16* WGL = (bf16*)(P.ws + WS_WGL); bf16* WBA = (bf16*)(P.ws + WS_WBA); bf16* WBG = (bf16*)(P.ws + WS_WBG);
    bf16* WOUT = (bf16*)(P.ws + WS_WOUT); bf16* WUP = (bf16*)(P.ws + WS_WUP); bf16* WDN = (bf16*)(P.ws + WS_WDN); bf16* XN = (bf16*)(P.ws + WS_XN);
    constexpr int I_IN = 16 * (NPROJ / 32), I_BA = 8 * 32, I_BG = 16 * 32, I_OUT = 16 * 32, I_UP = 16 * 128, I_DN = 64 * 32;
    constexpr int NITEMS = I_IN + I_BA + I_BG + I_OUT + I_UP + I_DN;
    static_assert(NITEMS == P0_NITEMS && I_IN == P0_I_IN, "item counts");
    for (int it = gw; it < I_IN; it += NGW) { const int nb = it % (NPROJ / 32), kb = it / (NPROJ / 32); p0_item(P.w_in, D_IN, win_src_col(32 * nb), 64 * kb, WIN, 1024, 32 * nb, nullptr, scr, F.lane); }
    for (int idx = gw * 64 + F.lane; idx < 16 * 1024; idx += NGW * 64) { const int j = idx & 15, k = idx >> 4; WGL[j * 1024 + k] = (bf16)f2bf(P.w_in[(size_t)k * D_IN + GLOW_COL + j]); }
    for (int m = gw; m < M; m += NGW) {
        const GAS f32x4* xr = (const GAS f32x4*)(P.x + (size_t)m * DMODEL) + F.lane; const GAS f32x4* gr = (const GAS f32x4*)P.g1 + F.lane;
        f32x4 v[4]; float s = 0.f;
#pragma unroll
        for (int j = 0; j < 4; ++j) { v[j] = xr[64 * j]; s += (v[j].x * v[j].x + v[j].y * v[j].y) + (v[j].z * v[j].z + v[j].w * v[j].w); }
        const float rstd = rsqrtf(wave_sum(s) * (1.f / DMODEL) + 1e-6f);
        GAS unsigned long long* o8 = (GAS unsigned long long*)(XN + (size_t)m * DMODEL) + F.lane;
#pragma unroll
        for (int j = 0; j < 4; ++j) { const f32x4 g = gr[64 * j]; o8[64 * j] = (unsigned long long)pk2(v[j].x * rstd * g.x, v[j].y * rstd * g.y) | ((unsigned long long)pk2(v[j].z * rstd * g.z, v[j].w * rstd * g.w) << 32); }
    }
}
__device__ __forceinline__ void p1_glow(Frame& F, const Ptrs& P) {
    const bf16* XN = (const bf16*)(P.ws + WS_XN); const bf16* WGL = (const bf16*)(P.ws + WS_WGL); float* GLOW = (float*)(P.ws + WS_GLOW);
    const int gw = F.vcu * NWAVES + F.wave, NGW = F.G * NWAVES, rr = F.lane & 15, g = F.lane >> 4;
    LAS unsigned char* L = F.lds + RING_OFF;
    bf16x8 a0[16];
    { const GAS bf16* ap = (const GAS bf16*)XN + (size_t)((gw < M / 16 ? gw : 0) * 16 + rr) * 1024 + 8 * g;
#pragma unroll
      for (int ks = 0; ks < 16; ++ks) a0[ks] = *(const GAS bf16x8*)(ap + 32 * ks); }
#pragma unroll
    for (int i = 0; i < 4; ++i) { const int c = F.tid + 512 * i;
        *(LAS v4u*)(L + (c >> 7) * 2064 + (c & 127) * 16) = *(const GAS v4u*)((const GAS unsigned char*)WGL + (size_t)c * 16); }
    asm volatile("s_waitcnt lgkmcnt(0)" ::: "memory"); __builtin_amdgcn_s_barrier(); asm volatile("" ::: "memory");
    for (int grp = gw; grp < M / 16; grp += NGW) {
        const GAS bf16* ap = (const GAS bf16*)XN + (size_t)(grp * 16 + rr) * 1024 + 8 * g;
        if (grp != gw) {
#pragma unroll
            for (int ks = 0; ks < 16; ++ks) a0[ks] = *(const GAS bf16x8*)(ap + 32 * ks); }
        bf16x8 a1[16];
#pragma unroll
        for (int ks = 0; ks < 16; ++ks) a1[ks] = *(const GAS bf16x8*)(ap + 32 * (16 + ks));
        f32x4 acc = (f32x4){0.f, 0.f, 0.f, 0.f};
#pragma unroll
        for (int ks = 0; ks < 16; ++ks) { const bf16x8 b = *(const LAS bf16x8*)(L + rr * 2064 + (32 * ks + 8 * g) * 2); acc = __builtin_amdgcn_mfma_f32_16x16x32_bf16(a0[ks], b, acc, 0, 0, 0); }
#pragma unroll
        for (int ks = 0; ks < 16; ++ks) { const bf16x8 b = *(const LAS bf16x8*)(L + rr * 2064 + (32 * (16 + ks) + 8 * g) * 2); acc = __builtin_amdgcn_mfma_f32_16x16x32_bf16(a1[ks], b, acc, 0, 0, 0); }
#pragma unroll
        for (int r = 0; r < 4; ++r) GLOW[(size_t)(grp * 16 + 4 * g + r) * 16 + rr] = acc[r];
    }
    asm volatile("s_waitcnt lgkmcnt(0)" ::: "memory"); __builtin_amdgcn_s_barrier(); asm volatile("" ::: "memory");
}
__device__ __forceinline__ void p0_late_item(const Ptrs& P, int r, LAS float* scr, int lane) {
    bf16* WBA = (bf16*)(P.ws + WS_WBA); bf16* WBG = (bf16*)(P.ws + WS_WBG); bf16* WOUT = (bf16*)(P.ws + WS_WOUT); bf16* WUP = (bf16*)(P.ws + WS_WUP); bf16* WDN = (bf16*)(P.ws + WS_WDN);
    constexpr int I_BA = 4 * 32, I_BG = 8 * 32, I_OUT = 8 * 32, I_UP = 8 * 128;
    if (r < I_BA) { const int nb = r % 32, kb = r / 32; p0_item128(P.wba, 1024, 32 * nb, 128 * kb, WBA, 512, 32 * nb, nullptr, scr, lane); return; } r -= I_BA;
    if (r < I_BG) { const int nb = r % 32, kb = r / 32; p0_item128(P.wbg, 1024, 32 * nb, 128 * kb, WBG, 1024, 32 * nb, nullptr, scr, lane); return; } r -= I_BG;
    if (r < I_OUT) { const int nb = r % 32, kb = r / 32; p0_item128(P.wout, 1024, 32 * nb, 128 * kb, WOUT, 1024, 32 * nb, nullptr, scr, lane); return; } r -= I_OUT;
    if (r < I_UP) { const int nb = r % 128, kb = r / 128; p0_item128(P.wup, 4096, 32 * nb, 128 * kb, WUP, 1024, 32 * nb, P.g2, scr, lane); return; } r -= I_UP;
    { const int nb = r % 32, kb = r / 32; p0_item128(P.wdn, 1024, 32 * nb, 128 * kb, WDN, 4096, 32 * nb, nullptr, scr, lane); }
}
__device__ __forceinline__ void p1_late_weights(Frame& F, const Ptrs& P) {
    LAS float* scr = (LAS float*)(F.lds + RING_OFF + F.wave * 17408);
    unsigned* qw = (unsigned*)(F.ctl + CW_QUEUE + 256); volatile LAS unsigned* NX = F.MISC + 12;
    constexpr int NLATE = (P0_NITEMS - P0_I_IN) / 2, NB = (NLATE + 7) / 8;
    if (threadIdx.x == 0) NX[0] = __hip_atomic_fetch_add(qw, 1u, __ATOMIC_RELAXED, __HIP_MEMORY_SCOPE_AGENT);
    __syncthreads();
    int bi = __builtin_amdgcn_readfirstlane((int)NX[0]), par = 0;
    while (bi < NB) {
        unsigned nx = 0u; if (threadIdx.x == 0) nx = __hip_atomic_fetch_add(qw, 1u, __ATOMIC_RELAXED, __HIP_MEMORY_SCOPE_AGENT);
        const int r = bi * 8 + F.wave; if (r < NLATE) p0_late_item(P, r, scr, F.lane);
        if (threadIdx.x == 0) NX[par ^ 1] = nx;
        __syncthreads();
        bi = __builtin_amdgcn_readfirstlane((int)NX[par ^ 1]); par ^= 1;
    }
}
typedef short v4i16_t __attribute__((ext_vector_type(4)));
__device__ __forceinline__ v4i16_t tr16(const LAS unsigned char* p) { return __builtin_amdgcn_ds_read_tr16_b64_v4i16((LAS v4i16_t*)p); }
__device__ __forceinline__ float logsig(float z) { return fminf(z, 0.f) - 0.6931471805599453f * __builtin_amdgcn_logf(1.0f + __builtin_amdgcn_exp2f(-1.4426950408889634f * fabsf(z))); }
__device__ __forceinline__ float bflo(unsigned w) { return __uint_as_float(w << 16); }
__device__ __forceinline__ float bfhi(unsigned w) { return __uint_as_float(w & 0xffff0000u); }
#define WG_BAR() do { asm volatile("s_waitcnt vmcnt(0) lgkmcnt(0)" ::: "memory"); __builtin_amdgcn_s_barrier(); asm volatile("" ::: "memory"); } while (0)
#define WG_BAR_L() do { asm volatile("s_waitcnt lgkmcnt(0)" ::: "memory"); __builtin_amdgcn_s_barrier(); asm volatile("" ::: "memory"); } while (0)

__device__ __forceinline__ void gp_prefix2(const Ptrs& P, LAS unsigned char* L, int th, int c0, float (&p0)[16], float (&p1)[16], float& t0, float& t1) {
    float gu0[16], gu1[16];
    const GAS float* gpt = (const GAS float*)P.gup + c0; asm volatile("" : "+v"(gpt));
#pragma unroll
    for (int r = 0; r < 16; ++r) { typedef float f32x2_t __attribute__((ext_vector_type(2))); const f32x2_t t2 = *(const GAS f32x2_t*)(gpt + r * 512); gu0[r] = t2[0]; gu1[r] = t2[1]; }
    const float bias0 = P.gbias[c0], bias1 = P.gbias[c0 + 1];
    float r0 = 0.f, r1 = 0.f;
#pragma unroll
    for (int j = 0; j < 16; ++j) { const LAS f32x4* gp = (const LAS f32x4*)(L + (16 * th + j) * 64); float z0 = bias0, z1 = bias1;
#pragma unroll
        for (int q = 0; q < 4; ++q) { const f32x4 x = gp[q];
#pragma unroll
            for (int e = 0; e < 4; ++e) { z0 += x[e] * gu0[4 * q + e]; z1 += x[e] * gu1[4 * q + e]; } }
        r0 += logsig(z0) * 0.0625f; r1 += logsig(z1) * 0.0625f; p0[j] = r0; p1[j] = r1; }
    t0 = r0; t1 = r1;
}
__device__ __forceinline__ void gla_prep_unit(Frame& F, const Ptrs& P, int b, int n) {
    bf16* GQ = (bf16*)(P.ws + WS_GQ); bf16* GK = (bf16*)(P.ws + WS_GK); const float* GLOW = (const float*)(P.ws + WS_GLOW); float* GAM = (float*)(P.ws + WS_GAM);
    LAS unsigned char* L = F.lds + RING_OFF;
    const size_t t0 = (size_t)b * SEQ + 64 * n;
    const int cp = F.tid & 127, th = F.tid >> 7, ch = 4 * cp;
    if (F.tid < 256) *(LAS f32x4*)(L + F.tid * 16) = *(const f32x4*)(GLOW + t0 * 16 + F.tid * 4);
    typedef unsigned u32x2_t __attribute__((ext_vector_type(2)));
    u32x2_t q2[16], k2[16];
    { const GAS bf16* qp = (const GAS bf16*)GQ + (t0 + 16 * th) * 512 + ch; const GAS bf16* kp = (const GAS bf16*)GK + (t0 + 16 * th) * 512 + ch;
      _Pragma("unroll") for (int j = 0; j < 16; ++j) { q2[j] = *(const GAS u32x2_t*)qp; k2[j] = *(const GAS u32x2_t*)kp; qp += 512; kp += 512; asm volatile("" : "+v"(qp), "+v"(kp)); } }
    WG_BAR_L();
    float pa[16], pb[16], pc[16], pd[16]; float ta, tb, tc, td;
    gp_prefix2(P, L, th, ch, pa, pb, ta, tb);
    asm volatile("" ::: "memory");
    gp_prefix2(P, L, th, ch + 2, pc, pd, tc, td);
    const f32x4 tot = (f32x4){ta, tb, tc, td};
    *(LAS f32x4*)(L + 4096 + th * 2048 + ch * 4) = tot;
    WG_BAR_L();
    f32x4 E = (f32x4){0.f, 0.f, 0.f, 0.f};
#pragma unroll
    for (int t = 0; t < 3; ++t) { const f32x4 tt = *(const LAS f32x4*)(L + 4096 + t * 2048 + ch * 4); if (t < th) E += tt; }
    if (th == 3) { const f32x4 bl = E + (f32x4){pa[15], pb[15], pc[15], pd[15]}; f32x4 g4;
#pragma unroll
        for (int c = 0; c < 4; ++c) g4[c] = __builtin_amdgcn_exp2f(1.4426950408889634f * bl[c]);
        *(f32x4*)(GAM + ((size_t)b * 64 + n) * 512 + ch) = g4; }
    const float qs = 0.08838834764831845f;
    { GAS bf16* qp = (GAS bf16*)GQ + (t0 + 16 * th) * 512 + ch; GAS bf16* kp = (GAS bf16*)GK + (t0 + 16 * th) * 512 + ch;
      _Pragma("unroll") for (int j = 0; j < 16; ++j) { const f32x4 t4 = 1.4426950408889634f * (E + (f32x4){pa[j], pb[j], pc[j], pd[j]}); f32x4 e4, i4;
#pragma unroll
        for (int c = 0; c < 4; ++c) { e4[c] = __builtin_amdgcn_exp2f(t4[c]); i4[c] = __builtin_amdgcn_exp2f(-t4[c]); }
        u32x2_t qo, ko; qo.x = pk2(bflo(q2[j].x) * qs * e4[0], bfhi(q2[j].x) * qs * e4[1]); qo.y = pk2(bflo(q2[j].y) * qs * e4[2], bfhi(q2[j].y) * qs * e4[3]);
        ko.x = pk2(bflo(k2[j].x) * i4[0], bfhi(k2[j].x) * i4[1]); ko.y = pk2(bflo(k2[j].y) * i4[2], bfhi(k2[j].y) * i4[3]);
        *(GAS u32x2_t*)qp = qo; *(GAS u32x2_t*)kp = ko; qp += 512; kp += 512; asm volatile("" : "+v"(qp), "+v"(kp)); } }
    WG_BAR_L();
}


__device__ __forceinline__ void glds16g(const void* gsrc, unsigned lds_dst) { unsigned keep;
    asm volatile("s_mov_b32 %0, m0\n\ts_mov_b32 m0, %2\n\ts_nop 0\n\tglobal_load_lds_dwordx4 %1, off\n\ts_mov_b32 m0, %0" : "=&s"(keep) : "v"(gsrc), "s"(lds_dst) : "memory"); }

__device__ __forceinline__ float row_sum16(float v) {
    v += __builtin_bit_cast(float, __builtin_amdgcn_mov_dpp(__builtin_bit_cast(int, v), 0x128, 0xf, 0xf, false));
    v += __builtin_bit_cast(float, __builtin_amdgcn_mov_dpp(__builtin_bit_cast(int, v), 0x124, 0xf, 0xf, false));
    v += __builtin_bit_cast(float, __builtin_amdgcn_mov_dpp(__builtin_bit_cast(int, v), 0x122, 0xf, 0xf, false));
    v += __builtin_bit_cast(float, __builtin_amdgcn_mov_dpp(__builtin_bit_cast(int, v), 0x121, 0xf, 0xf, false));
    return v;
}

__device__ __forceinline__ void gla_fused64(Frame& F, const Ptrs& P, int u) {
    const int bh = u >> 2, es = u & 3, b = bh >> 2, h = bh & 3;
    const bf16* GQ = (const bf16*)(P.ws + WS_GQ); const bf16* GK = (const bf16*)(P.ws + WS_GK); const bf16* GV = (const bf16*)(P.ws + WS_GV); bf16* GO = (bf16*)(P.ws + WS_GO);
    const float* GAM = (const float*)(P.ws + WS_GAM); float* SSQ2 = (float*)(P.ws + WS_SSQ2);
    LAS unsigned char* L = F.lds + RING_OFF;
    LAS unsigned char* qt = L; LAS unsigned char* kt = L + 32768; LAS unsigned char* vt = L + 65536; LAS unsigned char* gt = L + 81920; LAS unsigned char* ost = L + 98304; LAS unsigned char* zst = L + 133120; LAS unsigned char* gmt = L + 151552;
    const unsigned lbase = (unsigned)(uintptr_t)L;
    const int ln = F.lane & 15, g = F.lane >> 4, w = F.wave, jt = w & 3, eh = w >> 2;
    f32x4 acc[4];
#pragma unroll
    for (int e2 = 0; e2 < 4; ++e2) acc[e2] = (f32x4){0.f, 0.f, 0.f, 0.f};
    const size_t rb = (size_t)b * SEQ;
    const int qrow0 = 8 * w + (F.lane >> 4), qrow1 = qrow0 + 4;
    const bf16* qs0 = GQ + (rb + qrow0) * 512 + h * 128 + (((F.lane & 15) ^ (qrow0 & 15)) << 3); const bf16* qs1 = GQ + (rb + qrow1) * 512 + h * 128 + (((F.lane & 15) ^ (qrow1 & 15)) << 3);
    const bf16* ks0 = GK + (rb + qrow0) * 512 + h * 128 + (((F.lane & 15) ^ (qrow0 & 15)) << 3); const bf16* ks1 = GK + (rb + qrow1) * 512 + h * 128 + (((F.lane & 15) ^ (qrow1 & 15)) << 3);
    const size_t vgo = (rb + 8 * w + (F.lane >> 3)) * 1024 + h * 256 + es * 64 + (F.lane & 7) * 8;
    const bf16* vs = GV + vgo; const bf16* gs = (const bf16*)GO + vgo;
    bf16* zp = GO + (rb + (F.tid >> 3)) * 1024 + h * 256 + es * 64 + (F.tid & 7) * 8;
    const float* gmp = GAM + (size_t)b * 64 * 512 + h * 128 + 16 * w + 4 * (F.lane & 3);
    const float gn0 = P.gnorm[64 * es + 32 * eh + ln], gn1 = P.gnorm[64 * es + 32 * eh + 16 + ln];
#define GF_DMA(n_) do { const int nn_ = (n_) < 64 ? (n_) : 63; const int sl_ = nn_ & 1; const size_t o5_ = (size_t)nn_ * 64 * 512, o1_ = (size_t)nn_ * 64 * 1024; \
        glds16g(qs0 + o5_, (unsigned)__builtin_amdgcn_readfirstlane(lbase + sl_ * 16384 + (2 * w) * 1024)); glds16g(qs1 + o5_, (unsigned)__builtin_amdgcn_readfirstlane(lbase + sl_ * 16384 + (2 * w + 1) * 1024)); \
        glds16g(ks0 + o5_, (unsigned)__builtin_amdgcn_readfirstlane(lbase + 32768 + sl_ * 16384 + (2 * w) * 1024)); glds16g(ks1 + o5_, (unsigned)__builtin_amdgcn_readfirstlane(lbase + 32768 + sl_ * 16384 + (2 * w + 1) * 1024)); \
        glds16g(vs + o1_, (unsigned)__builtin_amdgcn_readfirstlane(lbase + 65536 + sl_ * 8192 + w * 1024)); glds16g(gs + o1_, (unsigned)__builtin_amdgcn_readfirstlane(lbase + 81920 + sl_ * 8192 + w * 1024)); \
        if (F.lane < 4) glds16g(gmp + (size_t)nn_ * 512, (unsigned)__builtin_amdgcn_readfirstlane(lbase + 151552 + sl_ * 512 + w * 64)); } while (0)
#define GF_WAIT() asm volatile("s_waitcnt vmcnt(5) lgkmcnt(0)\n\ts_barrier" ::: "memory")
#define GF_OTILES() do { f32x4 o0 = (f32x4){0.f, 0.f, 0.f, 0.f}, o1 = (f32x4){0.f, 0.f, 0.f, 0.f}; \
        _Pragma("unroll") for (int k2i = 0; k2i < 2; ++k2i) { v4u wv; wv.x = pk_[2 * k2i][0]; wv.y = pk_[2 * k2i][1]; wv.z = pk_[2 * k2i + 1][0]; wv.w = pk_[2 * k2i + 1][1]; \
            const LAS unsigned char* tp = vb_ + (32 * k2i + 4 * g + (ln >> 2)) * 128 + (16 * (2 * eh) + 4 * (ln & 3)) * 2; \
            const v4i16_t lo0 = tr16(tp), hi0 = tr16(tp + 16 * 128), lo1 = tr16(tp + 32), hi1 = tr16(tp + 32 + 16 * 128); \
            o0 = __builtin_amdgcn_mfma_f32_16x16x32_bf16(__builtin_bit_cast(bf16x8, wv), (bf16x8){lo0[0], lo0[1], lo0[2], lo0[3], hi0[0], hi0[1], hi0[2], hi0[3]}, o0, 0, 0, 0); \
            o1 = __builtin_amdgcn_mfma_f32_16x16x32_bf16(__builtin_bit_cast(bf16x8, wv), (bf16x8){lo1[0], lo1[1], lo1[2], lo1[3], hi1[0], hi1[1], hi1[2], hi1[3]}, o1, 0, 0, 0); } \
        _Pragma("unroll") for (int ks = 0; ks < 4; ++ks) { const LAS unsigned char* sp = ost + sl * 17408 + (16 * (2 * eh) + ln) * 272 + (32 * ks + 8 * g) * 2; \
            const bf16x8 bs0 = *(const LAS bf16x8*)sp, bs1 = *(const LAS bf16x8*)(sp + 16 * 272); \
            o0 = __builtin_amdgcn_mfma_f32_16x16x32_bf16(bqd[ks], bs0, o0, 0, 0, 0); o1 = __builtin_amdgcn_mfma_f32_16x16x32_bf16(bqd[ks], bs1, o1, 0, 0, 0); } \
        float sq0[4], sq1[4]; \
        _Pragma("unroll") for (int r = 0; r < 4; ++r) { sq0[r] = row_sum16(o0[r] * o0[r]); sq1[r] = row_sum16(o1[r] * o1[r]); } \
        _Pragma("unroll") for (int r = 0; r < 4; ++r) { const int c_ = 16 * jt + 4 * g + r; \
            const unsigned short gv0 = *(const LAS unsigned short*)(gb_ + c_ * 128 + (16 * (2 * eh) + ln) * 2), gv1 = *(const LAS unsigned short*)(gb_ + c_ * 128 + (16 * (2 * eh + 1) + ln) * 2); \
            *(LAS unsigned short*)(zst + sl * 9216 + c_ * 144 + (16 * (2 * eh) + ln) * 2) = (unsigned short)f2bf(o0[r] * gn0 * __uint_as_float((unsigned)gv0 << 16)); \
            *(LAS unsigned short*)(zst + sl * 9216 + c_ * 144 + (16 * (2 * eh + 1) + ln) * 2) = (unsigned short)f2bf(o1[r] * gn1 * __uint_as_float((unsigned)gv1 << 16)); } \
        if (ln == 0) { _Pragma("unroll") for (int r = 0; r < 4; ++r) { float2 s2; s2.x = sq0[r]; s2.y = sq1[r]; *(float2*)(SSQ2 + ((t0_ + 16 * jt + 4 * g + r) * 4 + h) * 16 + 4 * es + 2 * eh) = s2; } } } while (0)
#define GF_STEP(n_) do { const int sl = (n_) & 1; const size_t t0_ = rb + (size_t)(n_) * 64; \
        GF_DMA((n_) + 1); \
        { const v4u zv_ = *(const LAS v4u*)(zst + (sl ^ 1) * 9216 + (F.tid >> 3) * 144 + (F.tid & 7) * 16); *(v4u*)(zp + (size_t)((n_) > 0 ? (n_) - 1 : 0) * 64 * 1024) = zv_; }     \
        const LAS unsigned char* qb_ = qt + sl * 16384; const LAS unsigned char* kb_ = kt + sl * 16384; const LAS unsigned char* vb_ = vt + sl * 8192; const LAS unsigned char* gb_ = gt + sl * 8192; \
        bf16x8 bqd[4]; \
        _Pragma("unroll") for (int ks = 0; ks < 4; ++ks) bqd[ks] = *(const LAS bf16x8*)(qb_ + (16 * jt + ln) * 256 + (((4 * ks + g) ^ ln) << 4)); \
        unsigned pk_[4][2]; \
        _Pragma("unroll") for (int i = 0; i < 4; ++i) { pk_[i][0] = 0u; pk_[i][1] = 0u; \
            if (i <= jt) { f32x4 s = (f32x4){0.f, 0.f, 0.f, 0.f}; \
                _Pragma("unroll") for (int ks = 0; ks < 4; ++ks) { const bf16x8 a = *(const LAS bf16x8*)(kb_ + (16 * i + ln) * 256 + (((4 * ks + g) ^ ln) << 4)); s = __builtin_amdgcn_mfma_f32_16x16x32_bf16(a, bqd[ks], s, 0, 0, 0); } \
                if (i == jt) { const int d_ = ln - 4 * g; s[0] = d_ >= 0 ? s[0] : 0.f; s[1] = d_ >= 1 ? s[1] : 0.f; s[2] = d_ >= 2 ? s[2] : 0.f; s[3] = d_ >= 3 ? s[3] : 0.f; } \
                pk_[i][0] = pk2(s[0], s[1]); pk_[i][1] = pk2(s[2], s[3]); } } \
        GF_OTILES(); \
        _Pragma("unroll") for (int ks = 0; ks < 2; ++ks) {                    \
            const int tr_ = 32 * ks + 8 * g + (ln >> 2); \
            const LAS unsigned char* tp = kb_ + tr_ * 256 + (((2 * w + ((ln & 3) >> 1)) ^ (tr_ & 15)) << 4) + (ln & 1) * 8; \
            const LAS unsigned char* tq = kb_ + (tr_ + 4) * 256 + (((2 * w + ((ln & 3) >> 1)) ^ ((tr_ + 4) & 15)) << 4) + (ln & 1) * 8; \
            const v4i16_t lo = tr16(tp), hi = tr16(tq); const bf16x8 af = (bf16x8){lo[0], lo[1], lo[2], lo[3], hi[0], hi[1], hi[2], hi[3]}; \
            _Pragma("unroll") for (int e2 = 0; e2 < 4; ++e2) { const LAS unsigned char* vp_ = vb_ + tr_ * 128 + (16 * e2 + 4 * (ln & 3)) * 2; \
                const v4i16_t vl = tr16(vp_), vh = tr16(vp_ + 4 * 128); \
                acc[e2] = __builtin_amdgcn_mfma_f32_16x16x32_bf16(af, (bf16x8){vl[0], vl[1], vl[2], vl[3], vh[0], vh[1], vh[2], vh[3]}, acc[e2], 0, 0, 0); } } \
        { const f32x4 gc_ = *(const LAS f32x4*)(gmt + sl * 512 + w * 64 + g * 16); \
          _Pragma("unroll") for (int e2 = 0; e2 < 4; ++e2) { acc[e2] = acc[e2] * gc_;                           \
            *(LAS unsigned long long*)(ost + (sl ^ 1) * 17408 + (16 * e2 + ln) * 272 + (16 * w + 4 * g) * 2) = (unsigned long long)pk2(acc[e2][0], acc[e2][1]) | ((unsigned long long)pk2(acc[e2][2], acc[e2][3]) << 32); } } \
        GF_WAIT(); } while (0)
    for (int i = F.tid; i < 17408 / 8; i += 512) *(LAS unsigned long long*)(ost + i * 8) = 0ull;
    for (int i = F.tid; i < 9216 / 8; i += 512) *(LAS unsigned long long*)(zst + 9216 + i * 8) = 0ull;
    GF_DMA(0);
    asm volatile("s_waitcnt vmcnt(0) lgkmcnt(0)\n\ts_barrier" ::: "memory");
    for (int n = 0; n < 64; ++n) GF_STEP(n);
    { const v4u zv_ = *(const LAS v4u*)(zst + 9216 + (F.tid >> 3) * 144 + (F.tid & 7) * 16); *(v4u*)(zp + (size_t)63 * 64 * 1024) = zv_; }
    asm volatile("s_waitcnt vmcnt(0) lgkmcnt(0)\n\ts_barrier" ::: "memory");
#undef GF_STEP
#undef GF_OTILES
#undef GF_WAIT
#undef GF_DMA
}
namespace moba {
typedef unsigned short bf16;
using bf16x8=__attribute__((ext_vector_type(8)))short;
using s16x4=__attribute__((ext_vector_type(4)))short;
using f32x16=__attribute__((ext_vector_type(16)))float;
using u32x4=__attribute__((ext_vector_type(4)))unsigned;
typedef float f32x4_t __attribute__((ext_vector_type(4)));
__device__ __forceinline__ unsigned f2bf_(float f){ unsigned u=__builtin_bit_cast(unsigned,f); return (u+0x7fffu+((u>>16)&1u))>>16; }
constexpr int BATCH=8,NHEAD=8,SEQ=4096,D=64,DM=NHEAD*D;
constexpr int NW=8,QBLK=32,QB=QBLK*NW,KVBLK=64,NQB=SEQ/QB;
constexpr int ATTN_PITCH=DM, ATTN_UNIT_ROWS=QB;
__device__ __forceinline__ int crow(int r,int hi){return (r&3)+8*(r>>2)+4*hi;}
#define SBAR() __builtin_amdgcn_sched_barrier(0)
__device__ __forceinline__ void cmask(f32x16&p0,f32x16&p1,int jb,int qrel,int hi){
  const float NEG=-INFINITY; int kb=64*jb+4*hi;
  #pragma unroll
  for(int r=0;r<16;++r){int kv=kb+(r&3)+8*(r>>2); if(kv>qrel)p0[r]=NEG; if(kv+32>qrel)p1[r]=NEG;}
}

constexpr int NSLOT=3, SLOTB=8192;
constexpr int LDS_K=0, LDS_V=NSLOT*SLOTB, LDS_WS=2*NSLOT*SLOTB, LDS_OST=LDS_WS+NW*64*4, LDS_BYTES=LDS_OST+NW*4096;
constexpr int L_TB=LDS_BYTES, L_SEL=L_TB+1024, L_KM=L_SEL+1024, L_END=L_KM+4352;
constexpr float LOG2E=1.4426950408889634f, NEGBIG=-1.0e30f;
constexpr float C2=0.125f*1.4426950408889634f;
__device__ __forceinline__ void glds16(const void*gsrc,unsigned lds_dst){unsigned keep;
  asm volatile("s_mov_b32 %0, m0\n\ts_mov_b32 m0, %2\n\ts_nop 0\n\tglobal_load_lds_dwordx4 %1, off\n\ts_mov_b32 m0, %0":"=&s"(keep):"v"(gsrc),"s"(lds_dst):"memory");}
__device__ __forceinline__ float max3f(float a,float b,float c){float r;asm("v_max3_f32 %0, %1, %2, %3":"=v"(r):"v"(a),"v"(b),"v"(c));return r;}
__device__ __forceinline__ float max2f(float a,float b){float r;asm("v_max_f32_e32 %0, %1, %2":"=v"(r):"v"(a),"v"(b));return r;}
__device__ __forceinline__ float fadd_s(float a,float b){float r;asm("v_add_f32_e32 %0, %1, %2":"=v"(r):"v"(a),"v"(b));return r;}
__device__ __forceinline__ float fsub_s(float a,float b){float r;asm("v_sub_f32_e32 %0, %1, %2":"=v"(r):"v"(a),"v"(b));return r;}
typedef float f32x2_t __attribute__((ext_vector_type(2))); typedef __bf16 bf16x2_t __attribute__((ext_vector_type(2)));
__device__ __forceinline__ unsigned cvtpk_s(float lo,float hi){f32x2_t v={lo,hi};bf16x2_t b=__builtin_convertvector(v,bf16x2_t);return __builtin_bit_cast(unsigned,b);}
#define WAIT_BAR(N) asm volatile("s_waitcnt vmcnt(" #N ") lgkmcnt(0)\n\ts_barrier":::"memory")

__device__ __forceinline__ void qkt(f32x16&p0,f32x16&p1,const char*Kslot,const bf16x8*qr,int r32,int hi){
  const char*kb=Kslot+hi*1024+r32*16;
  #pragma unroll
  for(int d0=0;d0<4;++d0){
    const bf16x8 b0=*reinterpret_cast<const bf16x8*>(kb+d0*2048);
    const bf16x8 b1=*reinterpret_cast<const bf16x8*>(kb+d0*2048+512);
    p0=__builtin_amdgcn_mfma_f32_32x32x16_bf16(b0,qr[d0],p0,0,0,0);p1=__builtin_amdgcn_mfma_f32_32x32x16_bf16(b1,qr[d0],p1,0,0,0);}
}
typedef __attribute__((address_space(3))) const char* lds_cptr;
typedef short v4i16_t __attribute__((ext_vector_type(4)));
__device__ __forceinline__ void kload8(bf16x8*kf,lds_cptr kp){
  kf[0]=*(const __attribute__((address_space(3))) bf16x8*)(kp);      kf[1]=*(const __attribute__((address_space(3))) bf16x8*)(kp+512);
  kf[2]=*(const __attribute__((address_space(3))) bf16x8*)(kp+2048); kf[3]=*(const __attribute__((address_space(3))) bf16x8*)(kp+2560);
  kf[4]=*(const __attribute__((address_space(3))) bf16x8*)(kp+4096); kf[5]=*(const __attribute__((address_space(3))) bf16x8*)(kp+4608);
  kf[6]=*(const __attribute__((address_space(3))) bf16x8*)(kp+6144); kf[7]=*(const __attribute__((address_space(3))) bf16x8*)(kp+6656);
}
__device__ __forceinline__ void kload2(bf16x8*kf,lds_cptr kp,int j){ kf[2*j]=*(const __attribute__((address_space(3))) bf16x8*)(kp+j*2048); kf[2*j+1]=*(const __attribute__((address_space(3))) bf16x8*)(kp+j*2048+512); }
__device__ __forceinline__ s16x4 vtr(lds_cptr p){ return __builtin_bit_cast(s16x4,__builtin_amdgcn_ds_read_tr16_b64_v4i16((__attribute__((address_space(3))) v4i16_t*)p)); }
__device__ __forceinline__ float rowmax(const f32x16&p0,const f32x16&p1){
  float a=max3f(p0[0],p0[1],p1[0]),b=max3f(p0[2],p0[3],p1[1]);a=max3f(a,p1[2],p1[3]);
  #pragma unroll
  for(int r=4;r<16;r+=4){a=max3f(a,p0[r],p0[r+1]);b=max3f(b,p0[r+2],p0[r+3]);a=max3f(a,p1[r],p1[r+1]);b=max3f(b,p1[r+2],p1[r+3]);}
  const float m=max2f(a,b);
  auto rr=__builtin_amdgcn_permlane32_swap(__float_as_uint(m),__float_as_uint(m),false,false);
  return max2f(__uint_as_float(rr[0]),__uint_as_float(rr[1]));
}
__device__ __forceinline__ void pv(f32x16*o,int vb,bf16x8 pa0,bf16x8 pa1,bf16x8 pa2,bf16x8 pa3){
  #pragma unroll
  for(int d0=0;d0<2;++d0){s16x4 lo[4],hi[4];
    #pragma unroll
    for(int ks=0;ks<4;++ks){
      asm volatile("ds_read_b64_tr_b16 %0,%1 offset:%c2":"=&v"(lo[ks]):"v"(vb),"i"(d0*4096+ks*1024):"memory");
      asm volatile("ds_read_b64_tr_b16 %0,%1 offset:%c2":"=&v"(hi[ks]):"v"(vb),"i"(d0*4096+ks*1024+512):"memory");}
    asm volatile("s_waitcnt lgkmcnt(0)":::"memory");SBAR();
    #define PK(k) (bf16x8){lo[k][0],lo[k][1],lo[k][2],lo[k][3],hi[k][0],hi[k][1],hi[k][2],hi[k][3]}
    o[d0]=__builtin_amdgcn_mfma_f32_32x32x16_bf16(pa0,PK(0),o[d0],0,0,0);
    o[d0]=__builtin_amdgcn_mfma_f32_32x32x16_bf16(pa1,PK(1),o[d0],0,0,0);
    o[d0]=__builtin_amdgcn_mfma_f32_32x32x16_bf16(pa2,PK(2),o[d0],0,0,0);
    o[d0]=__builtin_amdgcn_mfma_f32_32x32x16_bf16(pa3,PK(3),o[d0],0,0,0);
    #undef PK
  }
}

#ifndef ATTN_STORE16
#define ATTN_STORE16(p,v) (*(u32x4*)(p)=(v))
#endif
__device__ __forceinline__ int t5_bucket(int d){ if(d<16)return d; const int large=16+(int)(__logf((float)d*(1.0f/16.0f))/2.0794415416798357f*16.0f); return large<31?large:31; }
template<int THRL> __device__ __forceinline__ void attn_unit(int b,int h,int qb,const bf16*Q,const bf16*__restrict__ K,const bf16*__restrict__ V,bf16*O,const float*kmean,const float*t5,char*shm){
  const int tid=threadIdx.x,lane=tid&63,r32=lane&31,hi=lane>>5; const int wid=__builtin_amdgcn_readfirstlane(tid>>6);
  const long rowbase=(long)b*SEQ; const int q0=qb*QB;
  const bf16*Qw=Q+(rowbase+q0+wid*QBLK)*DM+h*D;
  const bf16*Kh=K+rowbase*DM+h*D,*Vh=V+rowbase*DM+h*D;
  const unsigned lds0=(unsigned)(uintptr_t)shm;
  float*wsf=(float*)(shm+LDS_WS)+wid*64;
  const int qrel=wid*QBLK+r32;
  typedef __attribute__((address_space(3))) float lds_f32; typedef __attribute__((address_space(3))) unsigned lds_u32;
  lds_f32*TB=(lds_f32*)((__attribute__((address_space(3))) char*)shm+L_TB); lds_u32*SEL=(lds_u32*)((__attribute__((address_space(3))) char*)shm+L_SEL); lds_f32*KM=(lds_f32*)((__attribute__((address_space(3))) char*)shm+L_KM);
  asm volatile("":"+s"(TB),"+v"(SEL),"+v"(KM));
  int lo_=lane; asm volatile("":"+v"(lo_));
  const bf16*ksrc=Kh+(long)lo_*DM+wid*8;
  const bf16*vsrc=Vh+(long)(16*(wid&3)+(lo_>>2))*DM+(wid>>2)*32+(lo_&3)*8;
  const unsigned kdst=lds0+LDS_K+wid*1024, vdst=lds0+LDS_V+wid*1024;
  #define PHYS(t) ((t)<4?4*qb+(t):((t)<8?4*qb-8+(t):(t)-8))
  #define DMA_K(t,slot) glds16(ksrc+(long)PHYS(t)*KVBLK*DM,(unsigned)__builtin_amdgcn_readfirstlane(kdst+(slot)))
  #define DMA_V(t,slot) glds16(vsrc+(long)PHYS(t)*KVBLK*DM,(unsigned)__builtin_amdgcn_readfirstlane(vdst+(slot)))
  const int vb0=(int)(lds0+LDS_V)+((lane>>4)&1)*32+(lane&3)*8+(4*hi+((lane&15)>>2))*64;
  const char*Kbase=shm+LDS_K; bf16x8 kf[8];
  const lds_cptr shm3=(lds_cptr)shm; const lds_cptr kp0=shm3+LDS_K+hi*1024+r32*16; const lds_cptr vp0=shm3+LDS_V+((lane>>4)&1)*32+(lane&3)*8+(4*hi+((lane&15)>>2))*64;
  const int NT=4*(qb+1);
  DMA_K(0,0);DMA_V(0,0);DMA_K(1,SLOTB);
  bf16x8 qr[4];
  #pragma unroll
  for(int d0=0;d0<4;++d0)qr[d0]=*reinterpret_cast<const bf16x8*>(&Qw[(long)r32*DM+d0*16+hi*8]);
  DMA_K(2,2*SLOTB);
  { int tt=tid; asm volatile("":"+v"(tt));
    { const int d_=tt-128; TB[tt]=d_<0?NEGBIG:t5[t5_bucket(d_<128?d_:128)*8+h]*LOG2E; } }
  for(int idx=tid;idx<1024;idx+=512)KM[(idx>>6)*68+(idx&63)]=(idx<qb*64)?kmean[((size_t)(b*16+(idx>>6))*8+h)*64+(idx&63)]:0.f;
  asm volatile("s_waitcnt vmcnt(0) lgkmcnt(0)\n\ts_barrier":::"memory");
  unsigned selm=0u;
  { f32x16 gacc=f32x16{};
    _Pragma("unroll") for(int d0=0;d0<4;++d0){ float kmv[8];
      { const f32x4_t ka=*(const __attribute__((address_space(3))) f32x4_t*)(KM+(r32&15)*68+16*d0+8*hi), kb=*(const __attribute__((address_space(3))) f32x4_t*)(KM+(r32&15)*68+16*d0+8*hi+4);
        _Pragma("unroll") for(int e=0;e<4;++e){ kmv[e]=r32<16?ka[e]:0.f; kmv[4+e]=r32<16?kb[e]:0.f; } }
      u32x4 wh,wl; float rs[8];
      wh[0]=cvtpk_s(kmv[0],kmv[1]);wh[1]=cvtpk_s(kmv[2],kmv[3]);wh[2]=cvtpk_s(kmv[4],kmv[5]);wh[3]=cvtpk_s(kmv[6],kmv[7]);
      _Pragma("unroll") for(int e=0;e<4;++e){ rs[2*e]=kmv[2*e]-__uint_as_float(wh[e]<<16); rs[2*e+1]=kmv[2*e+1]-__uint_as_float(wh[e]&0xffff0000u); }
      wl[0]=cvtpk_s(rs[0],rs[1]);wl[1]=cvtpk_s(rs[2],rs[3]);wl[2]=cvtpk_s(rs[4],rs[5]);wl[3]=cvtpk_s(rs[6],rs[7]);
      gacc=__builtin_amdgcn_mfma_f32_32x32x16_bf16(__builtin_bit_cast(bf16x8,wh),qr[d0],gacc,0,0,0);
      gacc=__builtin_amdgcn_mfma_f32_32x32x16_bf16(__builtin_bit_cast(bf16x8,wl),qr[d0],gacc,0,0,0); }
    float G[16];
    _Pragma("unroll") for(int r=0;r<8;++r){ auto rr=__builtin_amdgcn_permlane32_swap(__float_as_uint(gacc[r]),__float_as_uint(gacc[r]),false,false); G[(r&3)+8*(r>>2)]=__uint_as_float(rr[0]); G[(r&3)+8*(r>>2)+4]=__uint_as_float(rr[1]); }
    float v1=-INFINITY,v2=-INFINITY,v3=-INFINITY; int i1=-1,i2=-1,i3=-1;
    _Pragma("unroll") for(int j=0;j<15;++j) if(j<qb){ const float x=G[j];
      if(x>v1){v3=v2;i3=i2;v2=v1;i2=i1;v1=x;i1=j;} else if(x>v2){v3=v2;i3=i2;v2=x;i2=j;} else if(x>v3){v3=x;i3=j;} }
    selm=(i1>=0?1u<<i1:0u)|(i2>=0?1u<<i2:0u)|(i3>=0?1u<<i3:0u); }
  const float tb128=__builtin_bit_cast(float,__builtin_amdgcn_readfirstlane(__builtin_bit_cast(int,(float)TB[256])));
  float mhat=0.f,l_reg=0.f;f32x16 o[2];o[0]=f32x16{};o[1]=f32x16{};f32x16 negm=f32x16{};asm volatile("":"+v"(negm));
  #define PRE(P0,P1,t) do{ const float base_=addend-mhat; int qv_=qrel-4*hi; asm volatile("":"+v"(qv_));   \
      const int jb_=(t)&3; \
      if((t)<4&&64*jb_>32*wid+31){ _Pragma("unroll") for(int r=0;r<16;++r){ P0[r]=NEGBIG; P1[r]=NEGBIG; } }                                    \
      else if((t)<4&&32*wid-64*jb_-63<128){ const lds_f32*a_=TB+(69+qv_-64*jb_);   \
        _Pragma("unroll") for(int r=0;r<16;++r){ P0[r]=a_[59-((r&3)+8*(r>>2))]+base_; P1[r]=a_[27-((r&3)+8*(r>>2))]+base_; } } \
      else if((t)>=4&&(t)<8&&32*wid+65<64*jb_){ const lds_f32*a_=TB+(69+256+qv_-64*jb_); \
        _Pragma("unroll") for(int r=0;r<16;++r){ P0[r]=a_[59-((r&3)+8*(r>>2))]+base_; P1[r]=a_[27-((r&3)+8*(r>>2))]+base_; } } \
      else { const float bb_=(t)<8?base_+tb128:base_; _Pragma("unroll") for(int r=0;r<16;++r){ P0[r]=bb_; P1[r]=bb_; } }                         \
      asm volatile("":"+v"(P0),"+v"(P1)); }while(0)
  #define CMASK(P0,P1,t) do{}while(0)
  float addend=0.f;
  #define UPD(t) do{ if(((t)&3)==0&&(t)>=4){ const int blk_=(t)<8?qb-1:(((t)-8)>>2); const bool s_=(selm>>blk_)&1u; addend=s_?((t)<8?0.f:tb128):NEGBIG; \
      _Pragma("unroll") for(int r=0;r<16;++r)negm[r]=addend-mhat; asm volatile("":"+v"(negm)); } }while(0)
  bool resc=false;
  #define START(P0,P1) do{ const float rm=rowmax(P0,P1); resc=false; \
    { const float dl=rm; mhat=fadd_s(mhat,dl); \
      _Pragma("unroll") for(int r=0;r<16;++r){P0[r]=fsub_s(P0[r],dl);P1[r]=fsub_s(P1[r],dl);} \
      _Pragma("unroll") for(int r=0;r<16;++r)negm[r]=addend-mhat; asm volatile("":"+v"(negm)); } \
    _Pragma("unroll") for(int r=0;r<16;++r)P0[r]=__builtin_amdgcn_exp2f(P0[r]); }while(0)
  #define RESC() do{ if(resc){ asm volatile("s_waitcnt lgkmcnt(0)":::"memory"); \
      _Pragma("unroll") for(int d_=0;d_<2;++d_) _Pragma("unroll") for(int r=0;r<16;++r)o[d_][r]*=wsf[crow(r,hi)]; } }while(0)
  f32x16 pA0,pA1,pB0,pB1;
  int sl_prev=0,sl_cur=0,sl_next=SLOTB;
  #define ROT() do{sl_prev=sl_cur;sl_cur=sl_next;sl_next=(sl_next==(NSLOT-1)*SLOTB)?0:sl_next+SLOTB;}while(0)
  PRE(pA0,pA1,0); qkt(pA0,pA1,Kbase,qr,r32,hi);asm volatile("s_nop 15\n\ts_nop 7":"+v"(pA0),"+v"(pA1));
  START(pA0,pA1);
  _Pragma("unroll") for(int r=0;r<16;++r)pA1[r]=__builtin_amdgcn_exp2f(pA1[r]);
  WAIT_BAR(0);
  DMA_K(3,0);DMA_V(1,SLOTB);
  ROT();
  kload8(kf,kp0+sl_cur);
  WAIT_BAR(2);
  s16x4 vlo[8],vhi[8]; u32x4 pw0,pw1,pw2,pw3;
  #define PKW(P,B) cvtpk_s(P[B],P[B+1])
  #define PAF(k) __builtin_bit_cast(bf16x8,pw##k)
  #define VFR(i) (bf16x8){vlo[i][0],vlo[i][1],vlo[i][2],vlo[i][3],vhi[i][0],vhi[i][1],vhi[i][2],vhi[i][3]}
  #define PIN(x) asm volatile("":"+v"(x))
  #define MX3(a,b,c) __builtin_fmaxf(__builtin_fmaxf((a),(b)),(c))
  #define GAPA(MF,A0,A1,A2,A3,W0,W1,PW) do{ MF; sacc+=A0; sacc+=A1; sacc+=A2; sacc+=A3; PIN(sacc); W0; W1; PIN(PW); SBAR(); }while(0)
  #define EX(v) __builtin_amdgcn_exp2f(v)
  #define GAPB(MF,X,B) do{ MF; X[B]=EX(X[B]); X[B+1]=EX(X[B+1]); X[B+2]=EX(X[B+2]); X[B+3]=EX(X[B+3]); PIN(X); SBAR(); }while(0)
  #define VRD(i) do{ vlo[i]=vtr(vp_+(((i)>>2)*4096+((i)&3)*1024)); vhi[i]=vtr(vp_+(((i)>>2)*4096+((i)&3)*1024+512)); }while(0)
  #define KRD(G,j) do{ if(G){ kload2(kf,kp0+sl_next,j); SBAR(); } }while(0)
  #define STEP(C0,C1,P0,P1,t,GK,GV,GL,CI0,CI1) do{ SBAR(); \
    const lds_cptr vp_=vp0+sl_prev; \
    VRD(0); SBAR(); float sacc=(P0[0]+P0[1]); \
    GAPA(C0=__builtin_amdgcn_mfma_f32_32x32x16_bf16(kf[0],qr[0],CI0,0,0,0), P0[2],P0[3],P0[4],P0[5],     pw0[0]=PKW(P0,0), pw0[1]=PKW(P0,2), pw0); \
    VRD(4); SBAR(); GAPA(C1=__builtin_amdgcn_mfma_f32_32x32x16_bf16(kf[1],qr[0],CI1,0,0,0), P0[6],P0[7],P0[8],P0[9],     pw0[2]=PKW(P0,4), pw0[3]=PKW(P0,6), pw0); \
    VRD(1); SBAR(); GAPA(C0=__builtin_amdgcn_mfma_f32_32x32x16_bf16(kf[2],qr[1],C0,0,0,0),   P0[10],P0[11],P0[12],P0[13], pw1[0]=PKW(P0,8), pw1[1]=PKW(P0,10), pw1); \
    VRD(5); SBAR(); GAPA(C1=__builtin_amdgcn_mfma_f32_32x32x16_bf16(kf[3],qr[1],C1,0,0,0),   P0[14],P0[15],P1[0],P1[1],   pw1[2]=PKW(P0,12),pw1[3]=PKW(P0,14), pw1); \
    VRD(2); SBAR(); GAPA(C0=__builtin_amdgcn_mfma_f32_32x32x16_bf16(kf[4],qr[2],C0,0,0,0),   P1[2],P1[3],P1[4],P1[5],     pw2[0]=PKW(P1,0), pw2[1]=PKW(P1,2), pw2); \
    VRD(6); SBAR(); GAPA(C1=__builtin_amdgcn_mfma_f32_32x32x16_bf16(kf[5],qr[2],C1,0,0,0),   P1[6],P1[7],P1[8],P1[9],     pw2[2]=PKW(P1,4), pw2[3]=PKW(P1,6), pw2); \
    VRD(3); SBAR(); GAPA(C0=__builtin_amdgcn_mfma_f32_32x32x16_bf16(kf[6],qr[3],C0,0,0,0),   P1[10],P1[11],P1[12],P1[13], pw3[0]=PKW(P1,8), pw3[1]=PKW(P1,10), pw3); \
    VRD(7); SBAR(); GAPA(C1=__builtin_amdgcn_mfma_f32_32x32x16_bf16(kf[7],qr[3],C1,0,0,0),   P1[14],P1[15],0.f,0.f,       pw3[2]=PKW(P1,12),pw3[3]=PKW(P1,14), pw3); \
    l_reg+=sacc; \
    if(GK){DMA_K((t)+3,sl_cur);} if(GV){DMA_V((t)+1,sl_next);} \
    CMASK(C0,C1,t); \
    { float a=MX3(C0[0],C0[1],C1[0]),b=MX3(C0[2],C0[3],C1[1]); a=MX3(a,C1[2],C1[3]); \
      _Pragma("unroll") for(int r=4;r<16;r+=4){a=MX3(a,C0[r],C0[r+1]);b=MX3(b,C0[r+2],C0[r+3]);a=MX3(a,C1[r],C1[r+1]);b=MX3(b,C1[r+2],C1[r+3]);} \
      float rm=__builtin_fmaxf(a,b); { auto rr=__builtin_amdgcn_permlane32_swap(__float_as_uint(rm),__float_as_uint(rm),false,false); rm=__builtin_fmaxf(__uint_as_float(rr[0]),__uint_as_float(rr[1])); } \
      resc=false; \
      if(__builtin_expect(__any(rm>(float)THRL),0)){ const float dl=__builtin_fmaxf(rm,0.f); mhat+=dl; \
        _Pragma("unroll") for(int r=0;r<16;++r){C0[r]-=dl;C1[r]-=dl;} \
        _Pragma("unroll") for(int r=0;r<16;++r)negm[r]=addend-mhat; asm volatile("":"+v"(negm)); \
        const float f=__builtin_amdgcn_exp2f(-dl); l_reg*=f; if(hi==0)wsf[r32]=f; resc=true; } } \
    SBAR(); \
    GAPB(o[0]=__builtin_amdgcn_mfma_f32_32x32x16_bf16(PAF(0),VFR(0),o[0],0,0,0), C0,0); \
    GAPB(o[1]=__builtin_amdgcn_mfma_f32_32x32x16_bf16(PAF(0),VFR(4),o[1],0,0,0), C0,4); \
    KRD(GL,0); GAPB(o[0]=__builtin_amdgcn_mfma_f32_32x32x16_bf16(PAF(1),VFR(1),o[0],0,0,0), C0,8); \
    KRD(GL,1); GAPB(o[1]=__builtin_amdgcn_mfma_f32_32x32x16_bf16(PAF(1),VFR(5),o[1],0,0,0), C0,12); \
    KRD(GL,2); GAPB(o[0]=__builtin_amdgcn_mfma_f32_32x32x16_bf16(PAF(2),VFR(2),o[0],0,0,0), C1,0); \
    KRD(GL,3); GAPB(o[1]=__builtin_amdgcn_mfma_f32_32x32x16_bf16(PAF(2),VFR(6),o[1],0,0,0), C1,4); \
    GAPB(o[0]=__builtin_amdgcn_mfma_f32_32x32x16_bf16(PAF(3),VFR(3),o[0],0,0,0), C1,8); \
    GAPB(o[1]=__builtin_amdgcn_mfma_f32_32x32x16_bf16(PAF(3),VFR(7),o[1],0,0,0), C1,12); \
    }while(0)
  int t=1;
  #define ENDW(tt) do{ if((tt)+3<NT){WAIT_BAR(2);} else if((tt)+2<NT){WAIT_BAR(1);} else {WAIT_BAR(0);} }while(0)
  for(;t+1<NT&&t<9;t+=2){
    UPD(t);   PRE(pB0,pB1,t);   STEP(pB0,pB1,pA0,pA1,t,(t+3<NT),(t+1<NT),(t+1<NT),pB0,pB1);       ENDW(t);   RESC(); ROT();
    UPD(t+1); PRE(pA0,pA1,t+1); STEP(pA0,pA1,pB0,pB1,t+1,(t+4<NT),(t+2<NT),(t+2<NT),pA0,pA1);     ENDW(t+1); RESC(); ROT();
  }
  for(;t+5<NT;t+=2){
    UPD(t);   STEP(pB0,pB1,pA0,pA1,t,true,true,true,negm,negm);     WAIT_BAR(2); RESC(); ROT();
    UPD(t+1); STEP(pA0,pA1,pB0,pB1,t+1,true,true,true,negm,negm);   WAIT_BAR(2); RESC(); ROT();
  }
  for(;t+1<NT;t+=2){
    UPD(t);   PRE(pB0,pB1,t);   STEP(pB0,pB1,pA0,pA1,t,(t+3<NT),(t+1<NT),(t+1<NT),pB0,pB1);       ENDW(t);   RESC(); ROT();
    UPD(t+1); PRE(pA0,pA1,t+1); STEP(pA0,pA1,pB0,pB1,t+1,(t+4<NT),(t+2<NT),(t+2<NT),pA0,pA1);     ENDW(t+1); RESC(); ROT();
  }
  UPD(NT-1); PRE(pB0,pB1,NT-1);
  STEP(pB0,pB1,pA0,pA1,NT-1,false,false,false,pB0,pB1); RESC();
  { float sacc=pB0[0]+pB0[1]; _Pragma("unroll") for(int r=2;r<16;++r)sacc+=pB0[r]; _Pragma("unroll") for(int r=0;r<16;++r)sacc+=pB1[r]; l_reg+=sacc;
    pw0=(u32x4){PKW(pB0,0),PKW(pB0,2),PKW(pB0,4),PKW(pB0,6)};pw1=(u32x4){PKW(pB0,8),PKW(pB0,10),PKW(pB0,12),PKW(pB0,14)};pw2=(u32x4){PKW(pB1,0),PKW(pB1,2),PKW(pB1,4),PKW(pB1,6)};pw3=(u32x4){PKW(pB1,8),PKW(pB1,10),PKW(pB1,12),PKW(pB1,14)};
    SBAR(); pv(o,vb0+sl_cur,PAF(0),PAF(1),PAF(2),PAF(3)); }
  #undef PKW
  #undef PAF
  #undef VFR
  #undef PIN
  #undef MX3
  #undef GAPA
  #undef GAPB
  #undef EX
  #undef VRD
  #undef KRD
  #undef STEP
  #undef ENDW
  {auto rr=__builtin_amdgcn_permlane32_swap(__float_as_uint(l_reg),__float_as_uint(l_reg),false,false);l_reg=__uint_as_float(rr[0])+__uint_as_float(rr[1]);}
  if(hi==0)wsf[32+r32]=l_reg;asm volatile("s_waitcnt lgkmcnt(0)":::"memory");
  float rli[16];
  #pragma unroll
  for(int r=0;r<16;++r)rli[r]=__builtin_amdgcn_rcpf(wsf[32+crow(r,hi)]);
  bf16*Ow=O+(rowbase+q0+wid*QBLK)*DM+h*D;
  { bf16*stg=(bf16*)(shm+LDS_OST)+wid*2048;
    #pragma unroll
    for(int r=0;r<16;++r){const int orow=crow(r,hi);
      #pragma unroll
      for(int d0=0;d0<2;++d0)stg[orow*64+d0*32+r32]=(bf16)f2bf_(o[d0][r]*rli[r]);}
    asm volatile("s_waitcnt lgkmcnt(0)":::"memory");
    #pragma unroll
    for(int i=0;i<4;++i){const int row=i*8+(lane>>3),ch=lane&7; const u32x4 v=*(const u32x4*)(stg+row*64+ch*8); ATTN_STORE16(Ow+(long)row*DM+ch*8,v);} }
  asm volatile("s_waitcnt lgkmcnt(0)\n\ts_barrier":::"memory");
  #undef PHYS
  #undef PRE
  #undef UPD
  #undef DMA_K
  #undef DMA_V
  #undef CMASK
  #undef START
  #undef RESC
  #undef ROT
}
#undef SBAR
#undef WAIT_BAR
}
#ifndef SKIP_MOBA
#define SKIP_MOBA 0
#endif
struct Args { const float* in[15]; float* out; unsigned char* ws; int ph_lo, ph_hi; };
#define CAS __attribute__((address_space(4)))
__global__ void __launch_bounds__(NWAVES * 64, 2) hybrid_fwd(Args args) {
    extern __shared__ __attribute__((aligned(16))) unsigned char lds[];
    Frame F;
    F.lds = (LAS unsigned char*)lds;
    F.MISC = (volatile LAS unsigned*)(F.lds + MISC_OFF);
    F.tid = threadIdx.x; F.lane = F.tid & 63; F.wave = __builtin_amdgcn_readfirstlane(F.tid >> 6);
    F.G = gridDim.x; { const int bx = blockIdx.x; F.vcu = (F.G % 8 == 0) ? (bx % 8) * (F.G / 8) + bx / 8 : bx; }
    { const CAS Args* ap0 = (const CAS Args*)__builtin_amdgcn_kernarg_segment_ptr(); F.ctl = (gu32*)(ap0->ws + WS_CTL); }
#define PHASE_ARGS() const CAS Args* ap_ = (const CAS Args*)__builtin_amdgcn_kernarg_segment_ptr(); asm volatile("" : "+s"(ap_)); unsigned char* ws = ap_->ws; Ptrs P; \
    P.x = ap_->in[0]; P.g1 = ap_->in[1]; P.w_in = ap_->in[2]; P.qg = ap_->in[3]; P.kg = ap_->in[4]; P.t5 = ap_->in[5]; P.gup = ap_->in[6]; P.gbias = ap_->in[7]; \
    P.gnorm = ap_->in[8]; P.wba = ap_->in[9]; P.wbg = ap_->in[10]; P.wout = ap_->in[11]; P.g2 = ap_->in[12]; P.wup = ap_->in[13]; P.wdn = ap_->in[14]; P.out = ap_->out; P.ws = ws; \
    bf16* XN = (bf16*)(ws + WS_XN); bf16* H1B = (bf16*)(ws + WS_H1B); bf16* HB = (bf16*)(ws + WS_HB); float* SSQ = (float*)(ws + WS_SSQ); \
    bf16* QB_ = (bf16*)(ws + WS_Q); bf16* KB_ = (bf16*)(ws + WS_K); bf16* VB_ = (bf16*)(ws + WS_V); bf16* GO_ = (bf16*)(ws + WS_GO); bf16* MIX = (bf16*)(ws + WS_MIX); \
    bf16* SA = (bf16*)P.out; bf16* SG = (bf16*)P.out + (size_t)M * 1024; float* KMEAN = (float*)(ws + WS_KMEAN); \
    (void)XN; (void)H1B; (void)HB; (void)SSQ; (void)QB_; (void)KB_; (void)VB_; (void)GO_; (void)MIX; (void)SA; (void)SG; (void)KMEAN;
    for (int u = F.tid; u < (LDS_BYTES - LDSCTL_OFF) / 4; u += NWAVES * 64) ((LAS unsigned*)(F.lds + LDSCTL_OFF))[u] = 0u;
    __syncthreads();
    XcdBarrier bar; bar.bar = (unsigned*)(F.ctl + CW_BAR); bar.x = 0; bar.st = nullptr;
    if (N_LAUNCHES == 1) bar = xcd_barrier_post((unsigned*)(F.ctl + CW_BAR), F.MISC + 8);
#define GRID_BAR() do { if (N_LAUNCHES == 1) xcd_barrier(bar); } while (0)
    const int lo = args.ph_lo, hi = args.ph_hi;
#define IN(k) (lo <= (k) && (k) < hi)
#define BOTH(k) (IN(k) && IN((k) + 1))
    if (IN(0)) { PHASE_ARGS(); p0_prologue(F, P); if (BOTH(0)) GRID_BAR(); }
    if (IN(1)) { PHASE_ARGS();
        pg8::Gemm g{XN, (const bf16*)(ws + WS_WIN), M, NPROJ, DMODEL}; pg8::StaticOrder S; S.init(M, NPROJ, F.G, (int)blockIdx.x);
        {
        pg8::EpiProj E{QB_, KB_, VB_, (bf16*)(ws + WS_GV), SA, KMEAN, P.qg, P.kg};
        static_assert(WS_GQ == WS_V + 32 * MiB && WS_GK == WS_V + 64 * MiB && WS_GO == WS_GV + 64 * MiB, "EpiProj strides");
        pg8::gemm_phase<pg8::EpiProj, pg8::StaticOrder, true, true>(F.lds + RING_OFF, g, S, E); }
        p1_glow(F, P);
        if (BOTH(1)) GRID_BAR();
    }
    if (IN(2)) { PHASE_ARGS(); if (F.G == 256) for (int i = 0; i < 2; ++i) { const int U = F.vcu * 2 + i; gla_prep_unit(F, P, U >> 6, U & 63); } if (BOTH(2)) GRID_BAR(); }
    if (IN(3)) {
        if (F.G == 256 && (F.vcu & 1) == 0) { PHASE_ARGS(); gla_fused64(F, P, F.vcu >> 1); }
        { int t_ = threadIdx.x; asm volatile("" : "+v"(t_)); F.tid = t_; F.lane = t_ & 63; }
        PHASE_ARGS();
        if (F.G == 256) {
            const int bh = F.vcu >> 2, s = F.vcu & 3;
            const unsigned packed = s == 0 ? 0x1Fu : s == 1 ? 0x0678ADu : s == 2 ? 0x2Eu : 0x3459BCu; const int cnt = (s & 1) ? 6 : 2;
            for (int i = 0; i < cnt; ++i) { const int qb = (packed >> (4 * i)) & 15;
                moba::attn_unit<8>(bh >> 3, bh & 7, qb, QB_, KB_, VB_, QB_, KMEAN, P.t5, (char*)lds + RING_OFF); }
        }
        { PHASE_ARGS(); p1_late_weights(F, P); }
        if (BOTH(3)) GRID_BAR();
    }
    if (IN(4)) { PHASE_ARGS();
        { pg8::Gemm g{QB_, (const bf16*)(ws + WS_WBA), M, DMODEL, 512}; pg8::StaticOrder S; S.init(M, DMODEL, F.G, (int)blockIdx.x);
          pg8::EpiMix<false> E{SA, MIX, nullptr};
          pg8::gemm_phase<pg8::EpiMix<false>, pg8::StaticOrder, true, true>(F.lds + RING_OFF, g, S, E); }
        { pg8::Gemm g{GO_, (const bf16*)(ws + WS_WBG), M, DMODEL, DMODEL}; pg8::StaticOrder S; S.init(M, DMODEL, F.G, (int)blockIdx.x);
          pg8::EpiMix<true> E{SG, MIX, (const float*)(ws + WS_SSQ2)};
          pg8::gemm_phase<pg8::EpiMix<true>, pg8::StaticOrder, true, true>(F.lds + RING_OFF, g, S, E); }
        if (BOTH(4)) GRID_BAR();
    }
    if (IN(5)) { PHASE_ARGS();
        pg8::Gemm g{MIX, (const bf16*)(ws + WS_WOUT), M, DMODEL, DMODEL}; pg8::StaticOrder S; S.init(M, DMODEL, F.G, (int)blockIdx.x);
        pg8::EpiWout E{P.x, P.out, H1B, SSQ};
        pg8::gemm_phase<pg8::EpiWout, pg8::StaticOrder, true, true>(F.lds + RING_OFF, g, S, E);
        if (BOTH(5)) GRID_BAR();
    }
    if (IN(6)) { PHASE_ARGS();
        pg8::Gemm g{H1B, (const bf16*)(ws + WS_WUP), M, FF, DMODEL}; pg8::StaticOrder S; S.init(M, FF, F.G, (int)blockIdx.x);
        pg8::EpiUp E{SSQ, HB};
        pg8::gemm_phase<pg8::EpiUp, pg8::StaticOrder, true, true>(F.lds + RING_OFF, g, S, E);
        if (BOTH(6)) GRID_BAR();
    }
    if (IN(7)) { PHASE_ARGS();
        pg8::Gemm g{HB, (const bf16*)(ws + WS_WDN), M, DMODEL, FF}; pg8::StaticOrderRev S; S.init(M, DMODEL, F.G, (int)blockIdx.x);
        pg8::EpiDown E{H1B, P.out};
        pg8::gemm_phase<pg8::EpiDown, pg8::StaticOrderRev, true, true>(F.lds + RING_OFF, g, S, E);
    }
#undef IN
#undef BOTH
}
extern "C" void kernel_launch(void* const* d_in, const int* in_sizes, int n_in, void* d_out, int out_size, void* d_ws, size_t ws_size, hipStream_t stream) {
    static int grid = 0;
    if (grid == 0) {
        if (n_in != 15 || in_sizes[0] != M * DMODEL || out_size != M * DMODEL || ws_size < WS_END) { fprintf(stderr, "kernel_launch: unexpected shapes/workspace (n_in %d, in0 %d, out %d, ws %zu)\n", n_in, n_in > 0 ? in_sizes[0] : -1, out_size, ws_size); grid = -1; return; }
        int dev = 0, cus = 0, per_cu = 0;
        if (hipGetDevice(&dev) != hipSuccess || hipDeviceGetAttribute(&cus, hipDeviceAttributeMultiprocessorCount, dev) != hipSuccess) { grid = -1; return; }
        if (hipFuncSetAttribute((const void*)hybrid_fwd, hipFuncAttributeMaxDynamicSharedMemorySize, LDS_BYTES) != hipSuccess) { fprintf(stderr, "kernel_launch: hipFuncSetAttribute failed\n"); grid = -1; return; }
        if (hipOccupancyMaxActiveBlocksPerMultiprocessor(&per_cu, (const void*)hybrid_fwd, NWAVES * 64, LDS_BYTES) != hipSuccess || per_cu < 1)
            fprintf(stderr, "kernel_launch: note: occupancy query reports %d workgroups per CU\n", per_cu);
        (void)hipGetLastError();
        grid = cus;
        if (grid != 256) fprintf(stderr, "kernel_launch: %d CUs (built for 256)\n", grid);
    }
    if (grid < 0) return;
    if (hipMemsetAsync((char*)d_ws + WS_CTL, 0, CTL_ZERO_BYTES, stream) != hipSuccess) { fprintf(stderr, "kernel_launch: hipMemsetAsync failed\n"); return; }
    Args a{};
    for (int i = 0; i < 15; ++i) a.in[i] = (const float*)d_in[i];
    a.out = (float*)d_out; a.ws = (unsigned char*)d_ws;
    for (int li = 0; li < N_LAUNCHES; ++li) {
        a.ph_lo = (N_LAUNCHES == 1) ? 0 : li; a.ph_hi = (N_LAUNCHES == 1) ? N_PHASES : li + 1;
        hipLaunchKernelGGL(hybrid_fwd, dim3(grid), dim3(NWAVES * 64), LDS_BYTES, stream, a);
        const hipError_t le = hipPeekAtLastError();
        if (le != hipSuccess) { fprintf(stderr, "kernel_launch: launch %d failed: %s\n", li, hipGetErrorName(le)); break; }
    }
}
```

```cpp
#include <hip/hip_runtime.h>
#include <hip/hip_bf16.h>
#include <cstdio>
#include <cstdint>
#include <cmath>
namespace pg8 {
#define PG8_LAS __attribute__((address_space(3)))
typedef unsigned short bf16_t;
typedef short bf16x8 __attribute__((ext_vector_type(8)));
typedef float f32x4 __attribute__((ext_vector_type(4)));
typedef unsigned u32x4 __attribute__((ext_vector_type(4)));
constexpr int BM = 256, BK = 64, HALF = 128, HTB = HALF * BK * 2  , STAGE_BYTES = 8 * HTB, NXCD = 8, WGM = 4;

__host__ __device__ __forceinline__ int lds_byte(int r, int c) { const int st = (r >> 4) * 2 + (c >> 5), rr = r & 15, cc = c & 31, ob = rr * 64 + cc * 2; return st * 1024 + (ob ^ (((ob >> 9) & 1) << 5)); }
__host__ __device__ __forceinline__ void stage_rc(int b, int& R, int& C) { const int st = b / 1024, sb = b % 1024, swz = sb ^ (((sb >> 9) & 1) << 5); R = (st >> 1) * 16 + swz / 64; C = (st & 1) * 32 + (swz % 64) / 2; }
__host__ __device__ __forceinline__ int perm32(int rho) { const int n = rho >> 4, i = rho & 15; return 8 * (i >> 2) + 4 * n + (i & 3); }

struct Unit { int pm, pn; };
struct Gemm { const bf16_t* A; const bf16_t* Bt; int M, N, K; };

struct StaticOrder {
    int nM, nN, nwg, G, c;
    __host__ __device__ void init(int M, int N, int G_, int c_) { nM = M / BM; nN = N / BM; nwg = nM * nN; G = G_; c = c_; }
    __host__ __device__ bool next(int i, Unit& u) const {
        const long L = (long)i * G + c; if (L >= nwg) return false;
        int wgid = (int)L; { const int q = nwg / NXCD, r = nwg % NXCD, xcd = wgid % NXCD, off = wgid / NXCD; wgid = (xcd < r ? xcd * (q + 1) : r * (q + 1) + (xcd - r) * q) + off; }
        const int nig = WGM * nN, gid = wgid / nig, fm = gid * WGM, gsz = (nM - fm) < WGM ? (nM - fm) : WGM;
        u.pm = fm + ((wgid % nig) % gsz); u.pn = (wgid % nig) / gsz; return true;
    }
    __device__ __forceinline__ void a_ready(const Unit&) const {}
    __device__ __forceinline__ void done(const Unit&) const {}
};
struct StaticOrderRev : StaticOrder {
    int nr;
    __host__ __device__ void init(int M, int N, int G_, int c_) { StaticOrder::init(M, N, G_, c_); nr = (nwg + G - 1) / G; }
    __host__ __device__ bool next(int i, Unit& u) const { if (i >= nr) return false; return StaticOrder::next(nr - 1 - i, u); }
};

__device__ __forceinline__ unsigned cvt_pk_bf16(float lo, float hi) { unsigned r; asm volatile("v_cvt_pk_bf16_f32 %0, %1, %2" : "=v"(r) : "v"(lo), "v"(hi)); return r; }
typedef float f32x2 __attribute__((ext_vector_type(2)));
constexpr float RMS_EPS = 1e-6f;
constexpr float QC2 = 0.125f * 1.4426950408889634f;
struct EpiCtx { PG8_LAS unsigned char* stg; bool has_next; Unit nxt; int ui; };
__device__ __forceinline__ float bflo(unsigned w) { return __uint_as_float(w << 16); }
__device__ __forceinline__ float bfhi(unsigned w) { return __uint_as_float(w & 0xffff0000u); }
__device__ __forceinline__ float sigm(float v) { return __builtin_amdgcn_rcpf(1.0f + __expf(-v)); }
__device__ __forceinline__ u32x4 pack8(const f32x4& v0, const f32x4& v1) { u32x4 w; w.x = cvt_pk_bf16(v0[0], v0[1]); w.y = cvt_pk_bf16(v0[2], v0[3]); w.z = cvt_pk_bf16(v1[0], v1[1]); w.w = cvt_pk_bf16(v1[2], v1[3]); return w; }
__device__ __forceinline__ void stage_store(const u32x4 w, int it, PG8_LAS unsigned char* stg, int wr, int wc, int fr, int fq, bf16_t* rowp0, int pitch) {
    PG8_LAS unsigned char* slab = stg + (it & 1) * 8704;
    *(PG8_LAS u32x4*)(slab + (wr * 16 + fr) * 272 + (wc * 32 + 8 * fq) * 2) = w;
    asm volatile("s_waitcnt lgkmcnt(0)" ::: "memory"); __builtin_amdgcn_s_barrier(); asm volatile("" ::: "memory");
    const int r = threadIdx.x >> 4, c = threadIdx.x & 15;
    const u32x4 v = *(const PG8_LAS u32x4*)(slab + r * 272 + c * 16);
    __builtin_nontemporal_store(v, (u32x4*)(rowp0 + (size_t)(64 * (r >> 4) + (r & 15)) * pitch + 8 * c));
}

struct EpiProj {
    static constexpr bool PERM = true, AFTER_DRAIN = false, HAS_MID = false;
    bf16_t *Q, *Kb, *V, *GV, *SA; float* kmean; const float *qg, *kg;
    __device__ __forceinline__ void first(const Unit&, const EpiCtx&) const {}
    __device__ __forceinline__ void operator()(const f32x4 (&acc)[2][2][4][2], const Unit& u, int wr, int wc, int fr, int fq, const EpiCtx& X) const {
        const int pn = u.pn; const int row0 = u.pm * BM + wr * 64 + fr;
        if (pn < 4) {
            const bool isk = pn >= 2; const int head = (pn & 1) * 4 + wc;
            const float* gp = (isk ? kg : qg) + 8 * fq; const float sc = isk ? 1.0f : QC2;
            f32x4 g[2][2];
#pragma unroll
            for (int bj = 0; bj < 2; ++bj)
#pragma unroll
                for (int n = 0; n < 2; ++n) g[bj][n] = *(const f32x4*)(gp + bj * 32 + 4 * n) * sc;
            bf16_t* base = (isk ? Kb : Q) + head * 64 + 8 * fq;
            f32x4 cs[2][2];
#pragma unroll
            for (int bj = 0; bj < 2; ++bj)
#pragma unroll
                for (int n = 0; n < 2; ++n) cs[bj][n] = (f32x4){0.f, 0.f, 0.f, 0.f};
#pragma unroll
            for (int ai = 0; ai < 2; ++ai)
#pragma unroll
                for (int m = 0; m < 4; ++m) {
                    float ss = 0.f;
#pragma unroll
                    for (int bj = 0; bj < 2; ++bj)
#pragma unroll
                        for (int n = 0; n < 2; ++n) { const f32x4 x = acc[ai][bj][m][n]; ss += (x[0] * x[0] + x[1] * x[1]) + (x[2] * x[2] + x[3] * x[3]); }
                    ss += __shfl_xor(ss, 16); ss += __shfl_xor(ss, 32);
                    const float rstd = rsqrtf(ss * (1.0f / 64.0f) + RMS_EPS);
                    bf16_t* rowp = base + (size_t)(row0 + ai * HALF + m * 16) * 512;
#pragma unroll
                    for (int bj = 0; bj < 2; ++bj) { const f32x4 v0 = acc[ai][bj][m][0] * rstd * g[bj][0], v1 = acc[ai][bj][m][1] * rstd * g[bj][1];
                        cs[bj][0] += v0; cs[bj][1] += v1; *(u32x4*)(rowp + bj * 32) = pack8(v0, v1); }
                }
            if (isk) {
                float* km = kmean + ((size_t)u.pm * 8 + head) * 64 + 8 * fq;
#pragma unroll
                for (int bj = 0; bj < 2; ++bj)
#pragma unroll
                    for (int n = 0; n < 2; ++n)
#pragma unroll
                        for (int e = 0; e < 4; ++e) { float v = cs[bj][n][e]; v += __shfl_xor(v, 1); v += __shfl_xor(v, 2); v += __shfl_xor(v, 4); v += __shfl_xor(v, 8);
                            if (fr == 0) atomicAdd(km + bj * 32 + 4 * n + e, v * (1.0f / 256.0f)); }
            }
        } else {
            bf16_t* base; int pitch, t, act;
            if (pn < 10) { const int grp = (pn - 4) >> 1; base = V + (size_t)grp * (16u << 20); pitch = 512; t = (pn - 4) & 1; act = 0; }
            else if (pn < 18) { const int grp = (pn - 10) >> 2; base = GV + (size_t)grp * (32u << 20); pitch = 1024; t = (pn - 10) & 3; act = grp; }
            else { const int grp = (pn - 18) >> 2; base = SA + (size_t)grp * ((size_t)32768 * 1024); pitch = 1024; t = (pn - 18) & 3; act = 2; }
            bf16_t* tile0 = base + (size_t)(u.pm * BM) * pitch + t * BM;
            int it = 0;
#pragma unroll
            for (int ai = 0; ai < 2; ++ai)
#pragma unroll
                for (int m = 0; m < 4; ++m)
#pragma unroll
                    for (int bj = 0; bj < 2; ++bj) { f32x4 v0 = acc[ai][bj][m][0], v1 = acc[ai][bj][m][1];
                        if (act != 0) {
#pragma unroll
                            for (int e = 0; e < 4; ++e) { const float s0 = sigm(v0[e]), s1 = sigm(v1[e]); v0[e] = (act == 1) ? v0[e] * s0 : s0; v1[e] = (act == 1) ? v1[e] * s1 : s1; } }
                        stage_store(pack8(v0, v1), it++, X.stg, wr, wc, fr, fq, tile0 + (size_t)(ai * HALF + m * 16) * pitch + bj * HALF, pitch); }
        }
    }
};
template <bool ADD> struct EpiMix {
    static constexpr bool PERM = true, AFTER_DRAIN = false, HAS_MID = ADD;
    const bf16_t* S; bf16_t* MIX; const float* ssq2;
    __device__ __forceinline__ void fill_table(int pm, PG8_LAS float* tab) const {
        const int row = threadIdx.x >> 1, half = threadIdx.x & 1; float s2[2];
#pragma unroll
        for (int hh = 0; hh < 2; ++hh) { const f32x4* sp = (const f32x4*)(ssq2 + ((size_t)(pm * BM + row) * 4 + 2 * half + hh) * 16);
            const f32x4 t = (sp[0] + sp[1]) + (sp[2] + sp[3]); s2[hh] = rsqrtf(((t[0] + t[1]) + (t[2] + t[3])) * (1.0f / 256.0f) + RMS_EPS); }
        const float pa = __shfl_xor(s2[0], 1), pb = __shfl_xor(s2[1], 1);
        if (half == 0) { tab[256 + row] = s2[0] * __builtin_amdgcn_rcpf(s2[1]); tab[512 + row] = s2[1] * __builtin_amdgcn_rcpf(pa); }
        else { tab[768 + row] = s2[0] * __builtin_amdgcn_rcpf(s2[1]); tab[row] = s2[1]; }
        (void)pb;
    }
    __device__ __forceinline__ void first(const Unit& u, const EpiCtx& X) const { if (ADD) fill_table(u.pm, (PG8_LAS float*)(X.stg + 17408)); }
    __device__ __forceinline__ bool mid_at(int t) const { return t == 4 || t == 8 || t == 12; }
    __device__ __forceinline__ void mid(f32x4 (&acc)[2][2][4][2], const Unit& u, int wr, int wc, int fr, int fq, const EpiCtx& X, int t) const {
        const PG8_LAS float* tab = (const PG8_LAS float*)(X.stg + 17408 + 4096 * (X.ui & 1)) + (t >> 2) * 256;
#pragma unroll
        for (int ai = 0; ai < 2; ++ai)
#pragma unroll
            for (int m = 0; m < 4; ++m) { const float r = tab[ai * HALF + wr * 64 + m * 16 + fr];
#pragma unroll
                for (int bj = 0; bj < 2; ++bj)
#pragma unroll
                    for (int n = 0; n < 2; ++n) acc[ai][bj][m][n] = acc[ai][bj][m][n] * r; }
    }
    __device__ __forceinline__ void operator()(const f32x4 (&acc)[2][2][4][2], const Unit& u, int wr, int wc, int fr, int fq, const EpiCtx& X) const {
        const int row0 = u.pm * BM + wr * 64 + fr, col0 = u.pn * BM + wc * 32 + 8 * fq;
        const PG8_LAS float* tab = (const PG8_LAS float*)(X.stg + 17408 + 4096 * (X.ui & 1));
#pragma unroll
        for (int ai = 0; ai < 2; ++ai) {
            u32x4 sv[4][2], pv[4][2];
#pragma unroll
            for (int m = 0; m < 4; ++m) { const size_t off = (size_t)(row0 + ai * HALF + m * 16) * 1024 + col0;
#pragma unroll
                for (int bj = 0; bj < 2; ++bj) { sv[m][bj] = *(const u32x4*)(S + off + bj * HALF); if (ADD) pv[m][bj] = *(const u32x4*)(MIX + off + bj * HALF); } }
#pragma unroll
            for (int m = 0; m < 4; ++m) { const size_t off = (size_t)(row0 + ai * HALF + m * 16) * 1024 + col0; const float s3 = ADD ? tab[ai * HALF + wr * 64 + m * 16 + fr] : 1.0f;
#pragma unroll
                for (int bj = 0; bj < 2; ++bj) { const u32x4 s = sv[m][bj];
                    f32x4 v0 = acc[ai][bj][m][0] * s3 * (f32x4){bflo(s.x), bfhi(s.x), bflo(s.y), bfhi(s.y)}, v1 = acc[ai][bj][m][1] * s3 * (f32x4){bflo(s.z), bfhi(s.z), bflo(s.w), bfhi(s.w)};
                    if (ADD) { const u32x4 p = pv[m][bj]; v0 += (f32x4){bflo(p.x), bfhi(p.x), bflo(p.y), bfhi(p.y)}; v1 += (f32x4){bflo(p.z), bfhi(p.z), bflo(p.w), bfhi(p.w)}; }
                    *(u32x4*)(MIX + off + bj * HALF) = pack8(v0, v1); } } }
        if (ADD && X.has_next) fill_table(X.nxt.pm, (PG8_LAS float*)(X.stg + 17408 + 4096 * ((X.ui + 1) & 1)));
    }
};
struct EpiWout {
    static constexpr bool PERM = true, AFTER_DRAIN = false, HAS_MID = false;
    const float* x; float* out; bf16_t* H1B; float* ssq;
    __device__ __forceinline__ void first(const Unit&, const EpiCtx&) const {}
    __device__ __forceinline__ void operator()(const f32x4 (&acc)[2][2][4][2], const Unit& u, int wr, int wc, int fr, int fq, const EpiCtx& X) const {
        const int row0 = u.pm * BM + wr * 64 + fr, col0 = u.pn * BM + wc * 32 + 8 * fq;
#pragma unroll
        for (int ai = 0; ai < 2; ++ai) {
            f32x4 xv[4][2][2];
#pragma unroll
            for (int m = 0; m < 4; ++m) { const size_t off = (size_t)(row0 + ai * HALF + m * 16) * 1024 + col0;
#pragma unroll
                for (int bj = 0; bj < 2; ++bj) { xv[m][bj][0] = *(const f32x4*)(x + off + bj * HALF); xv[m][bj][1] = *(const f32x4*)(x + off + bj * HALF + 4); } }
#pragma unroll
            for (int m = 0; m < 4; ++m) { const int row = row0 + ai * HALF + m * 16; const size_t off = (size_t)row * 1024 + col0; float ss = 0.f;
#pragma unroll
                for (int bj = 0; bj < 2; ++bj) { const f32x4 h0 = xv[m][bj][0] + acc[ai][bj][m][0], h1 = xv[m][bj][1] + acc[ai][bj][m][1];
                    *(u32x4*)(H1B + off + bj * HALF) = pack8(h0, h1);
                    ss += (h0[0] * h0[0] + h0[1] * h0[1]) + (h0[2] * h0[2] + h0[3] * h0[3]) + (h1[0] * h1[0] + h1[1] * h1[1]) + (h1[2] * h1[2] + h1[3] * h1[3]); }
                ss += __shfl_xor(ss, 16); ss += __shfl_xor(ss, 32);
                if (fq == 0) ssq[(size_t)row * 16 + u.pn * 4 + wc] = ss; } }
    }
};
struct EpiUp {
    static constexpr bool PERM = true, AFTER_DRAIN = false, HAS_MID = false;
    const float* ssq; bf16_t* HB;
    __device__ __forceinline__ void table(const Unit& u, PG8_LAS float* tab, const f32x4& a, const f32x4& b) const {
        const f32x4 t = a + b; float s = (t[0] + t[1]) + (t[2] + t[3]); s += __shfl_xor(s, 1);
        if ((threadIdx.x & 1) == 0) tab[threadIdx.x >> 1] = rsqrtf(s * (1.0f / 1024.0f) + RMS_EPS);
    }
    __device__ __forceinline__ void first(const Unit& u, const EpiCtx& X) const {
        const f32x4* sp = (const f32x4*)(ssq + (size_t)(u.pm * BM + (threadIdx.x >> 1)) * 16 + (threadIdx.x & 1) * 8);
        table(u, (PG8_LAS float*)(X.stg + 17408), sp[0], sp[1]);
    }
    __device__ __forceinline__ void operator()(const f32x4 (&acc)[2][2][4][2], const Unit& u, int wr, int wc, int fr, int fq, const EpiCtx& X) const {
        f32x4 na = (f32x4){0.f, 0.f, 0.f, 0.f}, nb = na;
        if (X.has_next) { const f32x4* sp = (const f32x4*)(ssq + (size_t)(X.nxt.pm * BM + (threadIdx.x >> 1)) * 16 + (threadIdx.x & 1) * 8); na = sp[0]; nb = sp[1]; }
        const PG8_LAS float* tab = (const PG8_LAS float*)(X.stg + 17408 + 1024 * (X.ui & 1));
        bf16_t* tile0 = HB + (size_t)(u.pm * BM) * 4096 + u.pn * BM;
        int it = 0;
#pragma unroll
        for (int ai = 0; ai < 2; ++ai)
#pragma unroll
            for (int m = 0; m < 4; ++m) { const float rstd = tab[ai * HALF + wr * 64 + m * 16 + fr];
#pragma unroll
                for (int bj = 0; bj < 2; ++bj) { f32x4 v0 = acc[ai][bj][m][0] * rstd, v1 = acc[ai][bj][m][1] * rstd;
#pragma unroll
                    for (int e = 0; e < 4; ++e) { const float r0 = fmaxf(v0[e], 0.f), r1 = fmaxf(v1[e], 0.f); v0[e] = r0 * r0; v1[e] = r1 * r1; }
                    stage_store(pack8(v0, v1), it++, X.stg, wr, wc, fr, fq, tile0 + (size_t)(ai * HALF + m * 16) * 4096 + bj * HALF, 4096); } }
        if (X.has_next) table(X.nxt, (PG8_LAS float*)(X.stg + 17408 + 1024 * ((X.ui + 1) & 1)), na, nb);
    }
};
struct EpiDown {
    static constexpr bool PERM = false, AFTER_DRAIN = false, HAS_MID = false;
    const bf16_t* in; float* out;
    __device__ __forceinline__ void first(const Unit&, const EpiCtx&) const {}
    __device__ __forceinline__ void operator()(const f32x4 (&acc)[2][2][4][2], const Unit& u, int wr, int wc, int fr, int fq, const EpiCtx& X) const {
        typedef unsigned u32x2 __attribute__((ext_vector_type(2)));
        const int row0 = u.pm * BM + wr * 64 + fr, col0 = u.pn * BM + wc * 32 + 4 * fq;
        u32x2 h[2][4][2][2];
#pragma unroll
        for (int ai = 0; ai < 2; ++ai)
#pragma unroll
            for (int m = 0; m < 4; ++m) { const size_t ro = (size_t)(row0 + ai * HALF + m * 16) * 1024 + col0;
#pragma unroll
                for (int bj = 0; bj < 2; ++bj)
#pragma unroll
                    for (int n = 0; n < 2; ++n) h[ai][m][bj][n] = *(const u32x2*)(in + ro + bj * HALF + n * 16); }
#pragma unroll
        for (int ai = 0; ai < 2; ++ai)
#pragma unroll
            for (int m = 0; m < 4; ++m) { const size_t ro = (size_t)(row0 + ai * HALF + m * 16) * 1024 + col0;
#pragma unroll
                for (int bj = 0; bj < 2; ++bj)
#pragma unroll
                    for (int n = 0; n < 2; ++n) { const u32x2 hh = h[ai][m][bj][n];
                        *(f32x4*)(out + ro + bj * HALF + n * 16) = (f32x4){bflo(hh.x), bfhi(hh.x), bflo(hh.y), bfhi(hh.y)} + acc[ai][bj][m][n]; } }
    }
};

template <class Epi, class Sched, bool ALIGN_EPI = false, bool SP2 = false>
__device__ __forceinline__ void gemm_phase(PG8_LAS unsigned char* lds, const Gemm g, const Sched& S, const Epi& E) {
    const int tid = threadIdx.x, wid = __builtin_amdgcn_readfirstlane(tid >> 6), lane = tid & 63, wr = wid >> 2, wc = wid & 3, fr = lane & 15, fq = lane >> 4;
    const int K = g.K, nt = K / BK;
    unsigned voffA[2], voffB[2];
#pragma unroll
    for (int i = 0; i < 2; ++i) { int R, C; stage_rc(tid * 16 + i * 8192, R, C); const int Rb = Epi::PERM ? ((R & ~31) + perm32(R & 31)) : R;
        voffA[i] = (unsigned)(R * K + C) * 2u; voffB[i] = (unsigned)(Rb * K + C) * 2u; }
    const size_t kstep = (size_t)(BK * 2);
    const size_t hstep = (size_t)HALF * K * 2;
    const size_t tstep = 2 * hstep;
    const unsigned ldsw = (unsigned)wid * 1024u;
    const int aoff = lds_byte(wr * 64 + fr, fq * 8), boff = lds_byte(wc * 32 + fr, fq * 8);
#define PG8_SA(b, h) (((b) * 2 + (h)) * HTB)
#define PG8_SB(b, h) ((4 + (b) * 2 + (h)) * HTB)
#define PG8_STAGE(bufoff, gbase, voff) do { _Pragma("unroll") for (int _i = 0; _i < 2; ++_i) \
        __builtin_amdgcn_global_load_lds((const unsigned*)((const char*)(gbase) + (voff)[_i]), (PG8_LAS unsigned*)(lds + (bufoff) + ldsw + _i * 8192), 16, 0, 0); } while (0)
#define PG8_LDA(dst, b, h) do { _Pragma("unroll") for (int m = 0; m < 4; ++m) _Pragma("unroll") for (int k = 0; k < 2; ++k) dst[m][k] = *(const PG8_LAS bf16x8*)(lds + PG8_SA(b, h) + aoff + m * 2048 + k * 1024); } while (0)
#define PG8_LDB(dst, b, h) do { _Pragma("unroll") for (int n = 0; n < 2; ++n) _Pragma("unroll") for (int k = 0; k < 2; ++k) dst[n][k] = *(const PG8_LAS bf16x8*)(lds + PG8_SB(b, h) + boff + n * 2048 + k * 1024); } while (0)
#define PG8_MMA(ai, bj, At, Bt) do { __builtin_amdgcn_s_setprio(1); _Pragma("unroll") for (int m = 0; m < 4; ++m) _Pragma("unroll") for (int n = 0; n < 2; ++n) _Pragma("unroll") for (int k = 0; k < 2; ++k) \
        acc[ai][bj][m][n] = __builtin_amdgcn_mfma_f32_16x16x32_bf16(Bt[n][k], At[m][k], acc[ai][bj][m][n], 0, 0, 0); __builtin_amdgcn_s_setprio(0); } while (0)
#define PG8_WAIT_V(n) asm volatile("s_waitcnt vmcnt(" #n ")" ::: "memory")
#define PG8_WAIT_L(n) asm volatile("s_waitcnt lgkmcnt(" #n ")" ::: "memory")
#define PG8_BAR __builtin_amdgcn_s_barrier()
#define PG8_SCHED __builtin_amdgcn_sched_barrier(0)
    Unit cur, nxt; int ui = 0;
    if (!S.next(0, cur)) return;
    f32x4 acc[2][2][4][2];
#pragma unroll
    for (int a = 0; a < 2; ++a)
#pragma unroll
        for (int b = 0; b < 2; ++b)
#pragma unroll
            for (int m = 0; m < 4; ++m)
#pragma unroll
                for (int n = 0; n < 2; ++n) acc[a][b][m][n] = (f32x4){0.f, 0.f, 0.f, 0.f};
    bf16x8 At[4][2], B0[2][2], B1[2][2];
    const char* cA = (const char*)g.A + (size_t)cur.pm * tstep; const char* cB = (const char*)g.Bt + (size_t)cur.pn * tstep;
    S.a_ready(cur);
    EpiCtx X; X.stg = lds + STAGE_BYTES; X.ui = 0; X.has_next = false; X.nxt = cur;
    E.first(cur, X);
    if constexpr (SP2) {
        PG8_STAGE(PG8_SB(0, 0), cB, voffB); PG8_STAGE(PG8_SB(0, 1), cB + hstep, voffB); PG8_STAGE(PG8_SA(0, 0), cA, voffA); PG8_STAGE(PG8_SA(0, 1), cA + hstep, voffA);
        if (wr == 1) PG8_BAR;
        PG8_WAIT_V(2); PG8_BAR;
        PG8_STAGE(PG8_SB(1, 0), cB + kstep, voffB); PG8_STAGE(PG8_SA(1, 0), cA + kstep, voffA); PG8_STAGE(PG8_SB(1, 1), cB + hstep + kstep, voffB);
        PG8_WAIT_V(6); PG8_BAR;
    } else {
        PG8_STAGE(PG8_SB(0, 0), cB, voffB); PG8_STAGE(PG8_SA(0, 0), cA, voffA); PG8_STAGE(PG8_SB(0, 1), cB + hstep, voffB); PG8_STAGE(PG8_SA(0, 1), cA + hstep, voffA);
        if (wr == 1) PG8_BAR;
        PG8_WAIT_V(4); PG8_BAR;
        PG8_STAGE(PG8_SB(1, 0), cB + kstep, voffB); PG8_STAGE(PG8_SA(1, 0), cA + kstep, voffA); PG8_STAGE(PG8_SB(1, 1), cB + hstep + kstep, voffB);
        PG8_WAIT_V(6); PG8_BAR;
    }
    for (;;) {
        const bool has_next = S.next(ui + 1, nxt);
        const char* nA = has_next ? (const char*)g.A + (size_t)nxt.pm * tstep : cA; const char* nB = has_next ? (const char*)g.Bt + (size_t)nxt.pn * tstep : cB;
        X.ui = ui;
        for (int t = 0; t < nt; t += 2) {
            if constexpr (Epi::HAS_MID) { if (E.mid_at(t)) E.mid(acc, cur, wr, wc, fr, fq, X, t); }
            const bool last = (t == nt - 2);
            const char* a1 = cA + (size_t)(t + 1) * kstep;
            const char* a2 = last ? nA : cA + (size_t)(t + 2) * kstep; const char* b2 = last ? nB : cB + (size_t)(t + 2) * kstep;
            const char* a3 = a2 + kstep; const char* b3 = b2 + kstep;
            if (last && has_next) S.a_ready(nxt);
            if constexpr (SP2) {
            PG8_LDB(B0, 0, 0); PG8_LDB(B1, 0, 1); PG8_SCHED; PG8_LDA(At, 0, 0); PG8_STAGE(PG8_SA(1, 1), a1 + hstep, voffA);
            PG8_WAIT_V(8); PG8_WAIT_L(0); PG8_BAR; PG8_MMA(0, 0, At, B0); PG8_MMA(0, 1, At, B1); PG8_BAR; PG8_SCHED;
            PG8_LDA(At, 0, 1); PG8_STAGE(PG8_SB(0, 0), b2, voffB); PG8_STAGE(PG8_SB(0, 1), b2 + hstep, voffB); PG8_STAGE(PG8_SA(0, 0), a2, voffA);
            PG8_WAIT_V(8); PG8_WAIT_L(0); PG8_BAR; PG8_MMA(1, 0, At, B0); PG8_MMA(1, 1, At, B1); PG8_BAR; PG8_SCHED;
            PG8_LDB(B0, 1, 0); PG8_LDB(B1, 1, 1); PG8_SCHED; PG8_LDA(At, 1, 0); PG8_STAGE(PG8_SA(0, 1), a2 + hstep, voffA);
            PG8_WAIT_V(8); PG8_WAIT_L(0); PG8_BAR; PG8_MMA(0, 0, At, B0); PG8_MMA(0, 1, At, B1); PG8_BAR; PG8_SCHED;
            PG8_LDA(At, 1, 1); PG8_STAGE(PG8_SB(1, 0), b3, voffB); PG8_STAGE(PG8_SB(1, 1), b3 + hstep, voffB); PG8_STAGE(PG8_SA(1, 0), a3, voffA);
            PG8_WAIT_V(8); PG8_WAIT_L(0); PG8_BAR; PG8_MMA(1, 0, At, B0); PG8_MMA(1, 1, At, B1); PG8_BAR; PG8_SCHED;
            } else {
            PG8_LDB(B0, 0, 0); PG8_SCHED; PG8_LDA(At, 0, 0); PG8_STAGE(PG8_SA(1, 1), a1 + hstep, voffA);
            PG8_WAIT_L(8); PG8_BAR; PG8_WAIT_L(0); PG8_MMA(0, 0, At, B0); PG8_BAR; PG8_SCHED;
            PG8_LDB(B1, 0, 1); PG8_STAGE(PG8_SB(0, 0), b2, voffB);
            PG8_BAR; PG8_WAIT_L(0); PG8_MMA(0, 1, At, B1); PG8_BAR;
            PG8_LDA(At, 0, 1); PG8_STAGE(PG8_SA(0, 0), a2, voffA);
            PG8_BAR; PG8_WAIT_L(0); PG8_MMA(1, 0, At, B0); PG8_BAR; PG8_SCHED;
            PG8_STAGE(PG8_SB(0, 1), b2 + hstep, voffB);
            PG8_WAIT_V(6); PG8_BAR; PG8_MMA(1, 1, At, B1); PG8_BAR;
            PG8_LDB(B0, 1, 0); PG8_SCHED; PG8_LDA(At, 1, 0); PG8_STAGE(PG8_SA(0, 1), a2 + hstep, voffA);
            PG8_WAIT_L(8); PG8_BAR; PG8_WAIT_L(0); PG8_MMA(0, 0, At, B0); PG8_BAR; PG8_SCHED;
            PG8_LDB(B1, 1, 1); PG8_STAGE(PG8_SB(1, 0), b3, voffB);
            PG8_BAR; PG8_WAIT_L(0); PG8_MMA(0, 1, At, B1); PG8_BAR;
            PG8_LDA(At, 1, 1); PG8_STAGE(PG8_SA(1, 0), a3, voffA);
            PG8_BAR; PG8_WAIT_L(0); PG8_MMA(1, 0, At, B0); PG8_BAR; PG8_SCHED;
            PG8_STAGE(PG8_SB(1, 1), b3 + hstep, voffB);
            PG8_WAIT_V(6); PG8_BAR; PG8_MMA(1, 1, At, B1); PG8_BAR;
            }
        }
        if constexpr (ALIGN_EPI) { if (wr == 0) PG8_BAR; }
        if constexpr (!Epi::AFTER_DRAIN) { X.ui = ui; X.has_next = has_next; X.nxt = nxt; E(acc, cur, wr, wc, fr, fq, X); S.done(cur); }
        if (!has_next) break;
#pragma unroll
        for (int a = 0; a < 2; ++a)
#pragma unroll
            for (int b = 0; b < 2; ++b)
#pragma unroll
                for (int m = 0; m < 4; ++m)
#pragma unroll
                    for (int n = 0; n < 2; ++n) acc[a][b][m][n] = (f32x4){0.f, 0.f, 0.f, 0.f};
        cur = nxt; cA = nA; cB = nB; ++ui;
        if constexpr (ALIGN_EPI) { if (wr == 1) PG8_BAR; }
    }
    PG8_WAIT_V(0);
    if constexpr (!ALIGN_EPI) { if (wr == 0) PG8_BAR; }
    PG8_BAR;
    if constexpr (Epi::AFTER_DRAIN) { E.fused(acc, cur, wr, wc, fr, fq, lds, wid, lane); S.done(cur); }
#undef PG8_SA
#undef PG8_SB
#undef PG8_STAGE
#undef PG8_LDA
#undef PG8_LDB
#undef PG8_MMA
#undef PG8_WAIT_V
#undef PG8_WAIT_L
#undef PG8_BAR
#undef PG8_SCHED
}
}
constexpr int NWAVES = 8;
constexpr int BATCH = 8, SEQ = 4096, DMODEL = 1024, FF = 4096, M = BATCH * SEQ;
constexpr int D_IN = 6672, NPROJ = 6656;
constexpr int GLOW_COL = 3584;
#ifndef MK_N_LAUNCHES
#define MK_N_LAUNCHES 1
#endif
constexpr int N_PHASES = 8;
constexpr int N_LAUNCHES = MK_N_LAUNCHES;

constexpr size_t MiB = 1u << 20;
constexpr size_t WS_CTL = 0, WS_KMEAN = 1 * MiB, CTL_ZERO_BYTES = 2 * MiB;
constexpr size_t WS_SSQ = 2 * MiB, WS_GLOW = 4 * MiB, WS_GAM = 42 * MiB;
constexpr size_t WS_WIN = 6 * MiB, WS_WGL = 19 * MiB, WS_WBA = 20 * MiB, WS_WBG = 21 * MiB, WS_WOUT = 23 * MiB, WS_WUP = 25 * MiB, WS_WDN = 33 * MiB;
constexpr size_t WS_ST = 44 * MiB, WS_XN = 44 * MiB, WS_MIX = 44 * MiB;
constexpr size_t WS_Q = 172 * MiB, WS_K = 204 * MiB, WS_V = 236 * MiB, WS_GQ = 268 * MiB, WS_GK = 300 * MiB;
constexpr size_t WS_GV = 332 * MiB, WS_H1B = 332 * MiB;
constexpr size_t WS_GO = 396 * MiB;
constexpr size_t WS_HB = 44 * MiB;
constexpr size_t WS_SSQ2 = 460 * MiB;
constexpr size_t WS_END = 468 * MiB;
constexpr int CW_TMO = 0, CW_CODE = 1, CW_QUEUE = 1024, CW_BAR = 4096;

constexpr int RING_OFF = 0, RING_BYTES = 143360;
constexpr int LDSCTL_OFF = 163840 - 512, MISC_OFF = LDSCTL_OFF + 320;
constexpr int LDS_BYTES = 163840;
#define GAS __attribute__((address_space(1)))
#define LAS __attribute__((address_space(3)))
typedef unsigned short bf16;
typedef unsigned v4u __attribute__((ext_vector_type(4)));
typedef float f32x4 __attribute__((ext_vector_type(4)));
typedef short bf16x8 __attribute__((ext_vector_type(8)));
typedef GAS unsigned gu32;
typedef GAS unsigned long long gu64;
#define RLX_AGENT __ATOMIC_RELAXED, __HIP_MEMORY_SCOPE_AGENT
#define LDS_WAIT() asm volatile("s_waitcnt lgkmcnt(0)" ::: "memory")
#define VM_WAIT() asm volatile("s_waitcnt vmcnt(0)" ::: "memory")
__device__ __forceinline__ unsigned long long rt() { return __builtin_amdgcn_s_memrealtime(); }
__device__ __forceinline__ unsigned pk2(float lo, float hi) { typedef float f32x2_t __attribute__((ext_vector_type(2))); typedef __bf16 bf16x2_t __attribute__((ext_vector_type(2)));
    f32x2_t v = {lo, hi}; bf16x2_t b = __builtin_convertvector(v, bf16x2_t); return __builtin_bit_cast(unsigned, b); }
__device__ __forceinline__ unsigned f2bf(float f) { return pk2(f, 0.f) & 0xffffu; }
#define XB_TMO      128
#define XB_XCNT(j)  (256  + 64 * (j))
#define XB_XSUB(j)  (1280 + 64 * (j))
#define XB_XGEN(j)  (2304 + 64 * (j))
#define XB_TOP      3328
#define XB_TOPGEN   3392
#define XCD_BAR_WORDS 3456
#define XB_SPIN_CAP (1u << 18)

__device__ __forceinline__ unsigned xb_ld(unsigned* p)              { return __hip_atomic_load(p, __ATOMIC_RELAXED, __HIP_MEMORY_SCOPE_AGENT); }
__device__ __forceinline__ unsigned xb_add(unsigned* p, unsigned v) { return __hip_atomic_fetch_add(p, v, __ATOMIC_RELAXED, __HIP_MEMORY_SCOPE_AGENT); }
__device__ __forceinline__ unsigned xb_xcc_id() { return (unsigned)__builtin_amdgcn_s_getreg((3 << 11) | 20) & 0xFu; }
#define XB_SPIN(cond, bar) do { unsigned _sp = 0; while (cond) { __builtin_amdgcn_s_sleep(1); \
    if ((++_sp & 255u) == 0u) { if (xb_ld(&(bar)[XB_TMO])) break; if (_sp > XB_SPIN_CAP) { atomicAdd(&(bar)[XB_TMO], 1u); break; } } } } while (0)

struct XcdBarrier {
    unsigned* bar; unsigned x;
    volatile LAS unsigned* st;
};

__device__ __forceinline__ XcdBarrier xcd_barrier_post(unsigned* bar, volatile LAS unsigned* st) {
    XcdBarrier b; b.bar = bar; b.x = xb_xcc_id(); b.st = st;
    if (threadIdx.x == 0) (void)xb_add(&bar[XB_XCNT(b.x)], 1u);
    return b;
}
__device__ __forceinline__ void xcd_barrier_complete(unsigned* bar, unsigned x, unsigned& nloc, unsigned& nx) {
    const unsigned G = gridDim.x * gridDim.y * gridDim.z;
    unsigned sum, cnt, mine, sp = 0u;
    for (;;) {
        sum = 0u; cnt = 0u; mine = 0u;
#pragma unroll
        for (unsigned j = 0; j < 16; ++j) { const unsigned c = xb_ld(&bar[XB_XCNT(j)]); sum += c; cnt += (c > 0u) ? 1u : 0u; mine = (j == x) ? c : mine; }
        if (sum == G) break;
        __builtin_amdgcn_s_sleep(1);
        if ((++sp & 255u) == 0u) { if (xb_ld(&bar[XB_TMO])) break; if (sp > XB_SPIN_CAP) { atomicAdd(&bar[XB_TMO], 1u); break; } }
    }
    nloc = mine > 0u ? mine : 1u; nx = cnt > 0u ? cnt : 1u;
}

__device__ __forceinline__ void xcd_barrier(const XcdBarrier& b) {
    asm volatile("s_waitcnt vmcnt(0)" ::: "memory");
    __syncthreads();
    if (threadIdx.x == 0) {
        unsigned* bar = b.bar;
        __builtin_amdgcn_s_waitcnt(0);
        unsigned nloc = b.st[0], nx = b.st[1];
        if (nloc == 0u) { xcd_barrier_complete(bar, b.x, nloc, nx); b.st[0] = nloc; b.st[1] = nx; }
        const unsigned old = xb_add(&bar[XB_XSUB(b.x)], 1u);
        const unsigned gen = old / nloc;
        if (old + 1u == (gen + 1u) * nloc) {
            __builtin_amdgcn_fence(__ATOMIC_RELEASE, "agent");
            asm volatile("s_waitcnt vmcnt(0)" ::: "memory");
            const unsigned og = xb_add(&bar[XB_TOP], 1u);
            const unsigned tg = og / nx;
            if (og + 1u == (tg + 1u) * nx) xb_add(&bar[XB_TOPGEN], 1u);
            else XB_SPIN(xb_ld(&bar[XB_TOPGEN]) == tg, bar);
            __builtin_amdgcn_fence(__ATOMIC_ACQUIRE, "agent");
            xb_add(&bar[XB_XGEN(b.x)], 1u);
            asm volatile("s_waitcnt vmcnt(0)" ::: "memory");
        } else {
            XB_SPIN(xb_ld(&bar[XB_XGEN(b.x)]) == gen, bar);
            __builtin_amdgcn_fence(__ATOMIC_ACQUIRE, "agent");
            asm volatile("s_waitcnt vmcnt(0)" ::: "memory");
        }
    }
    __syncthreads();
}
struct Frame {
    LAS unsigned char* lds;
    volatile LAS unsigned* MISC;
    gu32* ctl;
    int tid, lane, wave;
    int vcu, G;
};
__device__ __forceinline__ float wave_sum(float v) {
#pragma unroll
    for (int o = 1; o < 64; o <<= 1) v += __shfl_xor(v, o);
    return v;
}
__device__ __forceinline__ void p0_item(const float* W, int ldw, int scol, int k0, bf16* WT, int K, int drow, const float* ks, LAS float* scr, int lane) {
#pragma unroll 8
    for (int i = 0; i < 32; ++i) { const int kk = 2 * i + (lane >> 5); float v = W[(size_t)(k0 + kk) * ldw + scol + (lane & 31)]; if (ks) v *= ks[k0 + kk]; scr[kk * 33 + (lane & 31)] = v; }
    LDS_WAIT(); asm volatile("" ::: "memory");
    const int c = lane & 7;
#pragma unroll
    for (int j = 0; j < 4; ++j) { const int n = (lane >> 3) + 8 * j; const LAS float* s = scr + (8 * c) * 33 + n;
        v4u o; o.x = pk2(s[0 * 33], s[1 * 33]); o.y = pk2(s[2 * 33], s[3 * 33]); o.z = pk2(s[4 * 33], s[5 * 33]); o.w = pk2(s[6 * 33], s[7 * 33]);
        *(GAS v4u*)(WT + (size_t)(drow + n) * K + k0 + 8 * c) = o; }
    LDS_WAIT(); asm volatile("" ::: "memory");
}
__device__ __forceinline__ void p0_item128(const float* W, int ldw, int scol, int k0, bf16* WT, int K, int drow, const float* ks, LAS float* scr, int lane) {
    float v[64];
#pragma unroll
    for (int i = 0; i < 64; ++i) { const int kk = 2 * i + (lane >> 5); v[i] = W[(size_t)(k0 + kk) * ldw + scol + (lane & 31)]; }
    if (ks) {
#pragma unroll
        for (int i = 0; i < 64; ++i) v[i] *= ks[k0 + 2 * i + (lane >> 5)]; }
#pragma unroll
    for (int i = 0; i < 64; ++i) scr[(2 * i + (lane >> 5)) * 33 + (lane & 31)] = v[i];
    LDS_WAIT(); asm volatile("" ::: "memory");
    const int c = lane & 7;
#pragma unroll
    for (int kc = 0; kc < 2; ++kc)
#pragma unroll
        for (int j = 0; j < 4; ++j) { const int n = (lane >> 3) + 8 * j; const LAS float* s = scr + (64 * kc + 8 * c) * 33 + n;
            v4u o; o.x = pk2(s[0 * 33], s[1 * 33]); o.y = pk2(s[2 * 33], s[3 * 33]); o.z = pk2(s[4 * 33], s[5 * 33]); o.w = pk2(s[6 * 33], s[7 * 33]);
            *(GAS v4u*)(WT + (size_t)(drow + n) * K + k0 + 64 * kc + 8 * c) = o; }
    LDS_WAIT(); asm volatile("" ::: "memory");
}
__device__ __forceinline__ int win_src_col(int n0) {
    const int tile = n0 >> 8, pt = n0 & 255;
    int lc = (tile < 4) ? (64 * ((pt >> 5) & 3) + 32 * (pt >> 7)) : pt;
    lc += 256 * tile; return lc >= GLOW_COL ? lc + 16 : lc;
}
struct Ptrs {
    const float *x, *g1, *w_in, *qg, *kg, *t5, *gup, *gbias, *gnorm, *wba, *wbg, *wout, *g2, *wup, *wdn;
    float* out; unsigned char* ws;
};
constexpr int P0_I_IN = 16 * (NPROJ / 32), P0_NITEMS = P0_I_IN + 8 * 32 + 16 * 32 + 16 * 32 + 16 * 128 + 64 * 32;
__device__ __forceinline__ void p0_prologue(Frame& F, const Ptrs& P) {
    LAS float* scr = (LAS float*)(F.lds + RING_OFF + F.wave * 16384);
    const int gw = F.vcu * NWAVES + F.wave, NGW = F.G * NWAVES;
    bf16* WIN = (bf16*)(P.ws + WS_WIN); bf16* WGL = (bf16*)(P.ws + WS_WGL); bf16* WBA = (bf16*)(P.ws + WS_WBA); bf16* WBG = (bf16*)(P.ws + WS_WBG);
    bf16* WOUT = (bf16*)(P.ws + WS_WOUT); bf16* WUP = (bf16*)(P.ws + WS_WUP); bf16* WDN = (bf16*)(P.ws + WS_WDN); bf16* XN = (bf16*)(P.ws + WS_XN);
    constexpr int I_IN = 16 * (NPROJ / 32), I_BA = 8 * 32, I_BG = 16 * 32, I_OUT = 16 * 32, I_UP = 16 * 128, I_DN = 64 * 32;
    constexpr int NITEMS = I_IN + I_BA + I_BG + I_OUT + I_UP + I_DN;
    static_assert(NITEMS == P0_NITEMS && I_IN == P0_I_IN, "item counts");
    for (int it = gw; it < I_IN; it += NGW) { const int nb = it % (NPROJ / 32), kb = it / (NPROJ / 32); p0_item(P.w_in, D_IN, win_src_col(32 * nb), 64 * kb, WIN, 1024, 32 * nb, nullptr, scr, F.lane); }
    for (int idx = gw * 64 + F.lane; idx < 16 * 1024; idx += NGW * 64) { const int j = idx & 15, k = idx >> 4; WGL[j * 1024 + k] = (bf16)f2bf(P.w_in[(size_t)k * D_IN + GLOW_COL + j]); }
    for (int m = gw; m < M; m += NGW) {
        const GAS f32x4* xr = (const GAS f32x4*)(P.x + (size_t)m * DMODEL) + F.lane; const GAS f32x4* gr = (const GAS f32x4*)P.g1 + F.lane;
        f32x4 v[4]; float s = 0.f;
#pragma unroll
        for (int j = 0; j < 4; ++j) { v[j] = xr[64 * j]; s += (v[j].x * v[j].x + v[j].y * v[j].y) + (v[j].z * v[j].z + v[j].w * v[j].w); }
        const float rstd = rsqrtf(wave_sum(s) * (1.f / DMODEL) + 1e-6f);
        GAS unsigned long long* o8 = (GAS unsigned long long*)(XN + (size_t)m * DMODEL) + F.lane;
#pragma unroll
        for (int j = 0; j < 4; ++j) { const f32x4 g = gr[64 * j]; o8[64 * j] = (unsigned long long)pk2(v[j].x * rstd * g.x, v[j].y * rstd * g.y) | ((unsigned long long)pk2(v[j].z * rstd * g.z, v[j].w * rstd * g.w) << 32); }
    }
}
__device__ __forceinline__ void p1_glow(Frame& F, const Ptrs& P) {
    const bf16* XN = (const bf16*)(P.ws + WS_XN); const bf16* WGL = (const bf16*)(P.ws + WS_WGL); float* GLOW = (float*)(P.ws + WS_GLOW);
    const int gw = F.vcu * NWAVES + F.wave, NGW = F.G * NWAVES, rr = F.lane & 15, g = F.lane >> 4;
    LAS unsigned char* L = F.lds + RING_OFF;
    bf16x8 a0[16];
    { const GAS bf16* ap = (const GAS bf16*)XN + (size_t)((gw < M / 16 ? gw : 0) * 16 + rr) * 1024 + 8 * g;
#pragma unroll
      for (int ks = 0; ks < 16; ++ks) a0[ks] = *(const GAS bf16x8*)(ap + 32 * ks); }
#pragma unroll
    for (int i = 0; i < 4; ++i) { const int c = F.tid + 512 * i;
        *(LAS v4u*)(L + (c >> 7) * 2064 + (c & 127) * 16) = *(const GAS v4u*)((const GAS unsigned char*)WGL + (size_t)c * 16); }
    asm volatile("s_waitcnt lgkmcnt(0)" ::: "memory"); __builtin_amdgcn_s_barrier(); asm volatile("" ::: "memory");
    for (int grp = gw; grp < M / 16; grp += NGW) {
        const GAS bf16* ap = (const GAS bf16*)XN + (size_t)(grp * 16 + rr) * 1024 + 8 * g;
        if (grp != gw) {
#pragma unroll
            for (int ks = 0; ks < 16; ++ks) a0[ks] = *(const GAS bf16x8*)(ap + 32 * ks); }
        bf16x8 a1[16];
#pragma unroll
        for (int ks = 0; ks < 16; ++ks) a1[ks] = *(const GAS bf16x8*)(ap + 32 * (16 + ks));
        f32x4 acc = (f32x4){0.f, 0.f, 0.f, 0.f};
#pragma unroll
        for (int ks = 0; ks < 16; ++ks) { const bf16x8 b = *(const LAS bf16x8*)(L + rr * 2064 + (32 * ks + 8 * g) * 2); acc = __builtin_amdgcn_mfma_f32_16x16x32_bf16(a0[ks], b, acc, 0, 0, 0); }
#pragma unroll
        for (int ks = 0; ks < 16; ++ks) { const bf16x8 b = *(const LAS bf16x8*)(L + rr * 2064 + (32 * (16 + ks) + 8 * g) * 2); acc = __builtin_amdgcn_mfma_f32_16x16x32_bf16(a1[ks], b, acc, 0, 0, 0); }
#pragma unroll
        for (int r = 0; r < 4; ++r) GLOW[(size_t)(grp * 16 + 4 * g + r) * 16 + rr] = acc[r];
    }
    asm volatile("s_waitcnt lgkmcnt(0)" ::: "memory"); __builtin_amdgcn_s_barrier(); asm volatile("" ::: "memory");
}
__device__ __forceinline__ void p0_late_item(const Ptrs& P, int r, LAS float* scr, int lane) {
    bf16* WBA = (bf16*)(P.ws + WS_WBA); bf16* WBG = (bf16*)(P.ws + WS_WBG); bf16* WOUT = (bf16*)(P.ws + WS_WOUT); bf16* WUP = (bf16*)(P.ws + WS_WUP); bf16* WDN = (bf16*)(P.ws + WS_WDN);
    constexpr int I_BA = 4 * 32, I_BG = 8 * 32, I_OUT = 8 * 32, I_UP = 8 * 128;
    if (r < I_BA) { const int nb = r % 32, kb = r / 32; p0_item128(P.wba, 1024, 32 * nb, 128 * kb, WBA, 512, 32 * nb, nullptr, scr, lane); return; } r -= I_BA;
    if (r < I_BG) { const int nb = r % 32, kb = r / 32; p0_item128(P.wbg, 1024, 32 * nb, 128 * kb, WBG, 1024, 32 * nb, nullptr, scr, lane); return; } r -= I_BG;
    if (r < I_OUT) { const int nb = r % 32, kb = r / 32; p0_item128(P.wout, 1024, 32 * nb, 128 * kb, WOUT, 1024, 32 * nb, nullptr, scr, lane); return; } r -= I_OUT;
    if (r < I_UP) { const int nb = r % 128, kb = r / 128; p0_item128(P.wup, 4096, 32 * nb, 128 * kb, WUP, 1024, 32 * nb, P.g2, scr, lane); return; } r -= I_UP;
    { const int nb = r % 32, kb = r / 32; p0_item128(P.wdn, 1024, 32 * nb, 128 * kb, WDN, 4096, 32 * nb, nullptr, scr, lane); }
}
__device__ __forceinline__ void p1_late_weights(Frame& F, const Ptrs& P) {
    LAS float* scr = (LAS float*)(F.lds + RING_OFF + F.wave * 17408);
    unsigned* qw = (unsigned*)(F.ctl + CW_QUEUE + 256); volatile LAS unsigned* NX = F.MISC + 12;
    constexpr int NLATE = (P0_NITEMS - P0_I_IN) / 2, NB = (NLATE + 7) / 8;
    if (threadIdx.x == 0) NX[0] = __hip_atomic_fetch_add(qw, 1u, __ATOMIC_RELAXED, __HIP_MEMORY_SCOPE_AGENT);
    __syncthreads();
    int bi = __builtin_amdgcn_readfirstlane((int)NX[0]), par = 0;
    while (bi < NB) {
        unsigned nx = 0u; if (threadIdx.x == 0) nx = __hip_atomic_fetch_add(qw, 1u, __ATOMIC_RELAXED, __HIP_MEMORY_SCOPE_AGENT);
        const int r = bi * 8 + F.wave; if (r < NLATE) p0_late_item(P, r, scr, F.lane);
        if (threadIdx.x == 0) NX[par ^ 1] = nx;
        __syncthreads();
        bi = __builtin_amdgcn_readfirstlane((int)NX[par ^ 1]); par ^= 1;
    }
}
typedef short v4i16_t __attribute__((ext_vector_type(4)));
__device__ __forceinline__ v4i16_t tr16(const LAS unsigned char* p) { return __builtin_amdgcn_ds_read_tr16_b64_v4i16((LAS v4i16_t*)p); }
__device__ __forceinline__ float logsig(float z) { return fminf(z, 0.f) - 0.6931471805599453f * __builtin_amdgcn_logf(1.0f + __builtin_amdgcn_exp2f(-1.4426950408889634f * fabsf(z))); }
__device__ __forceinline__ float bflo(unsigned w) { return __uint_as_float(w << 16); }
__device__ __forceinline__ float bfhi(unsigned w) { return __uint_as_float(w & 0xffff0000u); }
#define WG_BAR() do { asm volatile("s_waitcnt vmcnt(0) lgkmcnt(0)" ::: "memory"); __builtin_amdgcn_s_barrier(); asm volatile("" ::: "memory"); } while (0)
#define WG_BAR_L() do { asm volatile("s_waitcnt lgkmcnt(0)" ::: "memory"); __builtin_amdgcn_s_barrier(); asm volatile("" ::: "memory"); } while (0)

__device__ __forceinline__ void gla_prep_unit(Frame& F, const Ptrs& P, int b, int n) {
    bf16* GQ = (bf16*)(P.ws + WS_GQ); bf16* GK = (bf16*)(P.ws + WS_GK); const float* GLOW = (const float*)(P.ws + WS_GLOW); float* GAM = (float*)(P.ws + WS_GAM);
    LAS unsigned char* L = F.lds + RING_OFF;
    const size_t t0 = (size_t)b * SEQ + 64 * n;
    const int cp = F.tid & 255, th = F.tid >> 8, ch = 2 * cp;
    if (F.tid < 256) *(LAS f32x4*)(L + F.tid * 16) = *(const f32x4*)(GLOW + t0 * 16 + F.tid * 4);
    float gu0[16], gu1[16];
#pragma unroll
    for (int r = 0; r < 16; ++r) { gu0[r] = P.gup[r * 512 + ch]; gu1[r] = P.gup[r * 512 + ch + 1]; }
    const float bias0 = P.gbias[ch], bias1 = P.gbias[ch + 1];
    unsigned q2[32], k2[32];
    { const GAS bf16* qp = (const GAS bf16*)GQ + (t0 + 32 * th) * 512 + ch; const GAS bf16* kp = (const GAS bf16*)GK + (t0 + 32 * th) * 512 + ch;
      _Pragma("unroll") for (int j = 0; j < 32; ++j) { q2[j] = *(const GAS unsigned*)qp; k2[j] = *(const GAS unsigned*)kp; qp += 512; kp += 512; asm volatile("" : "+v"(qp), "+v"(kp)); } }
    WG_BAR_L();
    float p0[32], p1[32];
    { float r0 = 0.f, r1 = 0.f;
#pragma unroll
      for (int j = 0; j < 32; ++j) { const LAS f32x4* gp = (const LAS f32x4*)(L + (32 * th + j) * 64); float z0 = bias0, z1 = bias1;
#pragma unroll
          for (int q = 0; q < 4; ++q) { const f32x4 x = gp[q];
#pragma unroll
              for (int e = 0; e < 4; ++e) { z0 += x[e] * gu0[4 * q + e]; z1 += x[e] * gu1[4 * q + e]; } }
          r0 += logsig(z0) * 0.0625f; r1 += logsig(z1) * 0.0625f; p0[j] = r0; p1[j] = r1; }
      if (th == 0) { *(LAS float*)(L + 4096 + ch * 4) = r0; *(LAS float*)(L + 4096 + (ch + 1) * 4) = r1; } }
    WG_BAR_L();
    const float h0 = *(LAS float*)(L + 4096 + ch * 4), h1 = *(LAS float*)(L + 4096 + (ch + 1) * 4);
    const float E0 = th ? h0 : 0.f, E1 = th ? h1 : 0.f;
    if (th == 1) { float2 g2; g2.x = __expf(h0 + p0[31]); g2.y = __expf(h1 + p1[31]); *(float2*)(GAM + ((size_t)b * 64 + n) * 512 + ch) = g2; }
    const float qs = 0.08838834764831845f;
    { GAS bf16* qp = (GAS bf16*)GQ + (t0 + 32 * th) * 512 + ch; GAS bf16* kp = (GAS bf16*)GK + (t0 + 32 * th) * 512 + ch;
      _Pragma("unroll") for (int j = 0; j < 32; ++j) { const float b0 = E0 + p0[j], b1 = E1 + p1[j];
        const float t0 = 1.4426950408889634f * b0, t1 = 1.4426950408889634f * b1; const float e0 = __builtin_amdgcn_exp2f(t0), e1 = __builtin_amdgcn_exp2f(t1), i0 = __builtin_amdgcn_exp2f(-t0), i1 = __builtin_amdgcn_exp2f(-t1);
        *(GAS unsigned*)qp = pk2(bflo(q2[j]) * qs * e0, bfhi(q2[j]) * qs * e1); *(GAS unsigned*)kp = pk2(bflo(k2[j]) * i0, bfhi(k2[j]) * i1); qp += 512; kp += 512; asm volatile("" : "+v"(qp), "+v"(kp)); } }
    WG_BAR_L();
}


__device__ __forceinline__ void glds16g(const void* gsrc, unsigned lds_dst) { unsigned keep;
    asm volatile("s_mov_b32 %0, m0\n\ts_mov_b32 m0, %2\n\ts_nop 0\n\tglobal_load_lds_dwordx4 %1, off\n\ts_mov_b32 m0, %0" : "=&s"(keep) : "v"(gsrc), "s"(lds_dst) : "memory"); }

__device__ __forceinline__ float row_sum16(float v) {
    v += __builtin_bit_cast(float, __builtin_amdgcn_mov_dpp(__builtin_bit_cast(int, v), 0x128, 0xf, 0xf, false));
    v += __builtin_bit_cast(float, __builtin_amdgcn_mov_dpp(__builtin_bit_cast(int, v), 0x124, 0xf, 0xf, false));
    v += __builtin_bit_cast(float, __builtin_amdgcn_mov_dpp(__builtin_bit_cast(int, v), 0x122, 0xf, 0xf, false));
    v += __builtin_bit_cast(float, __builtin_amdgcn_mov_dpp(__builtin_bit_cast(int, v), 0x121, 0xf, 0xf, false));
    return v;
}

__device__ __forceinline__ void gla_fused64(Frame& F, const Ptrs& P, int u) {
    const int bh = u >> 2, es = u & 3, b = bh >> 2, h = bh & 3;
    const bf16* GQ = (const bf16*)(P.ws + WS_GQ); const bf16* GK = (const bf16*)(P.ws + WS_GK); const bf16* GV = (const bf16*)(P.ws + WS_GV); bf16* GO = (bf16*)(P.ws + WS_GO);
    const float* GAM = (const float*)(P.ws + WS_GAM); float* SSQ2 = (float*)(P.ws + WS_SSQ2);
    LAS unsigned char* L = F.lds + RING_OFF;
    LAS unsigned char* qt = L; LAS unsigned char* kt = L + 32768; LAS unsigned char* vt = L + 65536; LAS unsigned char* gt = L + 81920; LAS unsigned char* ost = L + 98304; LAS unsigned char* zst = L + 133120; LAS unsigned char* gmt = L + 151552;
    const unsigned lbase = (unsigned)(uintptr_t)L;
    const int ln = F.lane & 15, g = F.lane >> 4, w = F.wave, jt = w & 3, eh = w >> 2;
    f32x4 acc[4];
#pragma unroll
    for (int e2 = 0; e2 < 4; ++e2) acc[e2] = (f32x4){0.f, 0.f, 0.f, 0.f};
    const size_t rb = (size_t)b * SEQ;
    const int qrow0 = 8 * w + (F.lane >> 4), qrow1 = qrow0 + 4;
    const bf16* qs0 = GQ + (rb + qrow0) * 512 + h * 128 + (((F.lane & 15) ^ (qrow0 & 15)) << 3); const bf16* qs1 = GQ + (rb + qrow1) * 512 + h * 128 + (((F.lane & 15) ^ (qrow1 & 15)) << 3);
    const bf16* ks0 = GK + (rb + qrow0) * 512 + h * 128 + (((F.lane & 15) ^ (qrow0 & 15)) << 3); const bf16* ks1 = GK + (rb + qrow1) * 512 + h * 128 + (((F.lane & 15) ^ (qrow1 & 15)) << 3);
    const size_t vgo = (rb + 8 * w + (F.lane >> 3)) * 1024 + h * 256 + es * 64 + (F.lane & 7) * 8;
    const bf16* vs = GV + vgo; const bf16* gs = (const bf16*)GO + vgo;
    bf16* zp = GO + (rb + (F.tid >> 3)) * 1024 + h * 256 + es * 64 + (F.tid & 7) * 8;
    const float* gmp = GAM + (size_t)b * 64 * 512 + h * 128 + 16 * w + 4 * (F.lane & 3);
    const float gn0 = P.gnorm[64 * es + 32 * eh + ln], gn1 = P.gnorm[64 * es + 32 * eh + 16 + ln];
#define GF_DMA(n_) do { const int nn_ = (n_) < 64 ? (n_) : 63; const int sl_ = nn_ & 1; const size_t o5_ = (size_t)nn_ * 64 * 512, o1_ = (size_t)nn_ * 64 * 1024; \
        glds16g(qs0 + o5_, (unsigned)__builtin_amdgcn_readfirstlane(lbase + sl_ * 16384 + (2 * w) * 1024)); glds16g(qs1 + o5_, (unsigned)__builtin_amdgcn_readfirstlane(lbase + sl_ * 16384 + (2 * w + 1) * 1024)); \
        glds16g(ks0 + o5_, (unsigned)__builtin_amdgcn_readfirstlane(lbase + 32768 + sl_ * 16384 + (2 * w) * 1024)); glds16g(ks1 + o5_, (unsigned)__builtin_amdgcn_readfirstlane(lbase + 32768 + sl_ * 16384 + (2 * w + 1) * 1024)); \
        glds16g(vs + o1_, (unsigned)__builtin_amdgcn_readfirstlane(lbase + 65536 + sl_ * 8192 + w * 1024)); glds16g(gs + o1_, (unsigned)__builtin_amdgcn_readfirstlane(lbase + 81920 + sl_ * 8192 + w * 1024)); \
        if (F.lane < 4) glds16g(gmp + (size_t)nn_ * 512, (unsigned)__builtin_amdgcn_readfirstlane(lbase + 151552 + sl_ * 512 + w * 64)); } while (0)
#define GF_WAIT() asm volatile("s_waitcnt vmcnt(5) lgkmcnt(0)\n\ts_barrier" ::: "memory")
#define GF_OTILES() do { f32x4 o0 = (f32x4){0.f, 0.f, 0.f, 0.f}, o1 = (f32x4){0.f, 0.f, 0.f, 0.f}; \
        _Pragma("unroll") for (int k2i = 0; k2i < 2; ++k2i) { v4u wv; wv.x = pk_[2 * k2i][0]; wv.y = pk_[2 * k2i][1]; wv.z = pk_[2 * k2i + 1][0]; wv.w = pk_[2 * k2i + 1][1]; \
            const LAS unsigned char* tp = vb_ + (32 * k2i + 4 * g + (ln >> 2)) * 128 + (16 * (2 * eh) + 4 * (ln & 3)) * 2; \
            const v4i16_t lo0 = tr16(tp), hi0 = tr16(tp + 16 * 128), lo1 = tr16(tp + 32), hi1 = tr16(tp + 32 + 16 * 128); \
            o0 = __builtin_amdgcn_mfma_f32_16x16x32_bf16(__builtin_bit_cast(bf16x8, wv), (bf16x8){lo0[0], lo0[1], lo0[2], lo0[3], hi0[0], hi0[1], hi0[2], hi0[3]}, o0, 0, 0, 0); \
            o1 = __builtin_amdgcn_mfma_f32_16x16x32_bf16(__builtin_bit_cast(bf16x8, wv), (bf16x8){lo1[0], lo1[1], lo1[2], lo1[3], hi1[0], hi1[1], hi1[2], hi1[3]}, o1, 0, 0, 0); } \
        _Pragma("unroll") for (int ks = 0; ks < 4; ++ks) { const LAS unsigned char* sp = ost + sl * 17408 + (16 * (2 * eh) + ln) * 272 + (32 * ks + 8 * g) * 2; \
            const bf16x8 bs0 = *(const LAS bf16x8*)sp, bs1 = *(const LAS bf16x8*)(sp + 16 * 272); \
            o0 = __builtin_amdgcn_mfma_f32_16x16x32_bf16(bqd[ks], bs0, o0, 0, 0, 0); o1 = __builtin_amdgcn_mfma_f32_16x16x32_bf16(bqd[ks], bs1, o1, 0, 0, 0); } \
        float sq0[4], sq1[4]; \
        _Pragma("unroll") for (int r = 0; r < 4; ++r) { sq0[r] = row_sum16(o0[r] * o0[r]); sq1[r] = row_sum16(o1[r] * o1[r]); } \
        _Pragma("unroll") for (int r = 0; r < 4; ++r) { const int c_ = 16 * jt + 4 * g + r; \
            const unsigned short gv0 = *(const LAS unsigned short*)(gb_ + c_ * 128 + (16 * (2 * eh) + ln) * 2), gv1 = *(const LAS unsigned short*)(gb_ + c_ * 128 + (16 * (2 * eh + 1) + ln) * 2); \
            *(LAS unsigned short*)(zst + sl * 9216 + c_ * 144 + (16 * (2 * eh) + ln) * 2) = (unsigned short)f2bf(o0[r] * gn0 * __uint_as_float((unsigned)gv0 << 16)); \
            *(LAS unsigned short*)(zst + sl * 9216 + c_ * 144 + (16 * (2 * eh + 1) + ln) * 2) = (unsigned short)f2bf(o1[r] * gn1 * __uint_as_float((unsigned)gv1 << 16)); } \
        if (ln == 0) { _Pragma("unroll") for (int r = 0; r < 4; ++r) { float2 s2; s2.x = sq0[r]; s2.y = sq1[r]; *(float2*)(SSQ2 + ((t0_ + 16 * jt + 4 * g + r) * 4 + h) * 16 + 4 * es + 2 * eh) = s2; } } } while (0)
#define GF_STEP(n_) do { const int sl = (n_) & 1; const size_t t0_ = rb + (size_t)(n_) * 64; \
        GF_DMA((n_) + 1); \
        { const v4u zv_ = *(const LAS v4u*)(zst + (sl ^ 1) * 9216 + (F.tid >> 3) * 144 + (F.tid & 7) * 16); *(v4u*)(zp + (size_t)((n_) > 0 ? (n_) - 1 : 0) * 64 * 1024) = zv_; }     \
        const LAS unsigned char* qb_ = qt + sl * 16384; const LAS unsigned char* kb_ = kt + sl * 16384; const LAS unsigned char* vb_ = vt + sl * 8192; const LAS unsigned char* gb_ = gt + sl * 8192; \
        bf16x8 bqd[4]; \
        _Pragma("unroll") for (int ks = 0; ks < 4; ++ks) bqd[ks] = *(const LAS bf16x8*)(qb_ + (16 * jt + ln) * 256 + (((4 * ks + g) ^ ln) << 4)); \
        unsigned pk_[4][2]; \
        _Pragma("unroll") for (int i = 0; i < 4; ++i) { pk_[i][0] = 0u; pk_[i][1] = 0u; \
            if (i <= jt) { f32x4 s = (f32x4){0.f, 0.f, 0.f, 0.f}; \
                _Pragma("unroll") for (int ks = 0; ks < 4; ++ks) { const bf16x8 a = *(const LAS bf16x8*)(kb_ + (16 * i + ln) * 256 + (((4 * ks + g) ^ ln) << 4)); s = __builtin_amdgcn_mfma_f32_16x16x32_bf16(a, bqd[ks], s, 0, 0, 0); } \
                if (i == jt) { const int d_ = ln - 4 * g; s[0] = d_ >= 0 ? s[0] : 0.f; s[1] = d_ >= 1 ? s[1] : 0.f; s[2] = d_ >= 2 ? s[2] : 0.f; s[3] = d_ >= 3 ? s[3] : 0.f; } \
                pk_[i][0] = pk2(s[0], s[1]); pk_[i][1] = pk2(s[2], s[3]); } } \
        GF_OTILES(); \
        _Pragma("unroll") for (int ks = 0; ks < 2; ++ks) {                    \
            const int tr_ = 32 * ks + 8 * g + (ln >> 2); \
            const LAS unsigned char* tp = kb_ + tr_ * 256 + (((2 * w + ((ln & 3) >> 1)) ^ (tr_ & 15)) << 4) + (ln & 1) * 8; \
            const LAS unsigned char* tq = kb_ + (tr_ + 4) * 256 + (((2 * w + ((ln & 3) >> 1)) ^ ((tr_ + 4) & 15)) << 4) + (ln & 1) * 8; \
            const v4i16_t lo = tr16(tp), hi = tr16(tq); const bf16x8 af = (bf16x8){lo[0], lo[1], lo[2], lo[3], hi[0], hi[1], hi[2], hi[3]}; \
            _Pragma("unroll") for (int e2 = 0; e2 < 4; ++e2) { const LAS unsigned char* vp_ = vb_ + tr_ * 128 + (16 * e2 + 4 * (ln & 3)) * 2; \
                const v4i16_t vl = tr16(vp_), vh = tr16(vp_ + 4 * 128); \
                acc[e2] = __builtin_amdgcn_mfma_f32_16x16x32_bf16(af, (bf16x8){vl[0], vl[1], vl[2], vl[3], vh[0], vh[1], vh[2], vh[3]}, acc[e2], 0, 0, 0); } } \
        { const f32x4 gc_ = *(const LAS f32x4*)(gmt + sl * 512 + w * 64 + g * 16); \
          _Pragma("unroll") for (int e2 = 0; e2 < 4; ++e2) { acc[e2] = acc[e2] * gc_;                           \
            *(LAS unsigned long long*)(ost + (sl ^ 1) * 17408 + (16 * e2 + ln) * 272 + (16 * w + 4 * g) * 2) = (unsigned long long)pk2(acc[e2][0], acc[e2][1]) | ((unsigned long long)pk2(acc[e2][2], acc[e2][3]) << 32); } } \
        GF_WAIT(); } while (0)
    for (int i = F.tid; i < 17408 / 8; i += 512) *(LAS unsigned long long*)(ost + i * 8) = 0ull;
    for (int i = F.tid; i < 9216 / 8; i += 512) *(LAS unsigned long long*)(zst + 9216 + i * 8) = 0ull;
    GF_DMA(0);
    asm volatile("s_waitcnt vmcnt(0) lgkmcnt(0)\n\ts_barrier" ::: "memory");
    for (int n = 0; n < 64; ++n) GF_STEP(n);
    { const v4u zv_ = *(const LAS v4u*)(zst + 9216 + (F.tid >> 3) * 144 + (F.tid & 7) * 16); *(v4u*)(zp + (size_t)63 * 64 * 1024) = zv_; }
    asm volatile("s_waitcnt vmcnt(0) lgkmcnt(0)\n\ts_barrier" ::: "memory");
#undef GF_STEP
#undef GF_OTILES
#undef GF_WAIT
#undef GF_DMA
}
namespace moba {
typedef unsigned short bf16;
using bf16x8=__attribute__((ext_vector_type(8)))short;
using s16x4=__attribute__((ext_vector_type(4)))short;
using f32x16=__attribute__((ext_vector_type(16)))float;
using u32x4=__attribute__((ext_vector_type(4)))unsigned;
typedef float f32x4_t __attribute__((ext_vector_type(4)));
__device__ __forceinline__ unsigned f2bf_(float f){ unsigned u=__builtin_bit_cast(unsigned,f); return (u+0x7fffu+((u>>16)&1u))>>16; }
constexpr int BATCH=8,NHEAD=8,SEQ=4096,D=64,DM=NHEAD*D;
constexpr int NW=8,QBLK=32,QB=QBLK*NW,KVBLK=64,NQB=SEQ/QB;
constexpr int ATTN_PITCH=DM, ATTN_UNIT_ROWS=QB;
__device__ __forceinline__ int crow(int r,int hi){return (r&3)+8*(r>>2)+4*hi;}
#define SBAR() __builtin_amdgcn_sched_barrier(0)
__device__ __forceinline__ void cmask(f32x16&p0,f32x16&p1,int jb,int qrel,int hi){
  const float NEG=-INFINITY; int kb=64*jb+4*hi;
  #pragma unroll
  for(int r=0;r<16;++r){int kv=kb+(r&3)+8*(r>>2); if(kv>qrel)p0[r]=NEG; if(kv+32>qrel)p1[r]=NEG;}
}

constexpr int NSLOT=3, SLOTB=8192;
constexpr int LDS_K=0, LDS_V=NSLOT*SLOTB, LDS_WS=2*NSLOT*SLOTB, LDS_OST=LDS_WS+NW*64*4, LDS_BYTES=LDS_OST+NW*4096;
constexpr int L_TB=LDS_BYTES, L_SEL=L_TB+1024, L_KM=L_SEL+1024, L_END=L_KM+4352;
constexpr float LOG2E=1.4426950408889634f, NEGBIG=-1.0e30f;
constexpr float C2=0.125f*1.4426950408889634f;
__device__ __forceinline__ void glds16(const void*gsrc,unsigned lds_dst){unsigned keep;
  asm volatile("s_mov_b32 %0, m0\n\ts_mov_b32 m0, %2\n\ts_nop 0\n\tglobal_load_lds_dwordx4 %1, off\n\ts_mov_b32 m0, %0":"=&s"(keep):"v"(gsrc),"s"(lds_dst):"memory");}
__device__ __forceinline__ float max3f(float a,float b,float c){float r;asm("v_max3_f32 %0, %1, %2, %3":"=v"(r):"v"(a),"v"(b),"v"(c));return r;}
__device__ __forceinline__ float max2f(float a,float b){float r;asm("v_max_f32_e32 %0, %1, %2":"=v"(r):"v"(a),"v"(b));return r;}
__device__ __forceinline__ float fadd_s(float a,float b){float r;asm("v_add_f32_e32 %0, %1, %2":"=v"(r):"v"(a),"v"(b));return r;}
__device__ __forceinline__ float fsub_s(float a,float b){float r;asm("v_sub_f32_e32 %0, %1, %2":"=v"(r):"v"(a),"v"(b));return r;}
typedef float f32x2_t __attribute__((ext_vector_type(2))); typedef __bf16 bf16x2_t __attribute__((ext_vector_type(2)));
__device__ __forceinline__ unsigned cvtpk_s(float lo,float hi){f32x2_t v={lo,hi};bf16x2_t b=__builtin_convertvector(v,bf16x2_t);return __builtin_bit_cast(unsigned,b);}
#define WAIT_BAR(N) asm volatile("s_waitcnt vmcnt(" #N ") lgkmcnt(0)\n\ts_barrier":::"memory")

__device__ __forceinline__ void qkt(f32x16&p0,f32x16&p1,const char*Kslot,const bf16x8*qr,int r32,int hi){
  const char*kb=Kslot+hi*1024+r32*16;
  #pragma unroll
  for(int d0=0;d0<4;++d0){
    const bf16x8 b0=*reinterpret_cast<const bf16x8*>(kb+d0*2048);
    const bf16x8 b1=*reinterpret_cast<const bf16x8*>(kb+d0*2048+512);
    p0=__builtin_amdgcn_mfma_f32_32x32x16_bf16(b0,qr[d0],p0,0,0,0);p1=__builtin_amdgcn_mfma_f32_32x32x16_bf16(b1,qr[d0],p1,0,0,0);}
}
typedef __attribute__((address_space(3))) const char* lds_cptr;
typedef short v4i16_t __attribute__((ext_vector_type(4)));
__device__ __forceinline__ void kload8(bf16x8*kf,lds_cptr kp){
  kf[0]=*(const __attribute__((address_space(3))) bf16x8*)(kp);      kf[1]=*(const __attribute__((address_space(3))) bf16x8*)(kp+512);
  kf[2]=*(const __attribute__((address_space(3))) bf16x8*)(kp+2048); kf[3]=*(const __attribute__((address_space(3))) bf16x8*)(kp+2560);
  kf[4]=*(const __attribute__((address_space(3))) bf16x8*)(kp+4096); kf[5]=*(const __attribute__((address_space(3))) bf16x8*)(kp+4608);
  kf[6]=*(const __attribute__((address_space(3))) bf16x8*)(kp+6144); kf[7]=*(const __attribute__((address_space(3))) bf16x8*)(kp+6656);
}
__device__ __forceinline__ void kload2(bf16x8*kf,lds_cptr kp,int j){ kf[2*j]=*(const __attribute__((address_space(3))) bf16x8*)(kp+j*2048); kf[2*j+1]=*(const __attribute__((address_space(3))) bf16x8*)(kp+j*2048+512); }
__device__ __forceinline__ s16x4 vtr(lds_cptr p){ return __builtin_bit_cast(s16x4,__builtin_amdgcn_ds_read_tr16_b64_v4i16((__attribute__((address_space(3))) v4i16_t*)p)); }
__device__ __forceinline__ float rowmax(const f32x16&p0,const f32x16&p1){
  float a=max3f(p0[0],p0[1],p1[0]),b=max3f(p0[2],p0[3],p1[1]);a=max3f(a,p1[2],p1[3]);
  #pragma unroll
  for(int r=4;r<16;r+=4){a=max3f(a,p0[r],p0[r+1]);b=max3f(b,p0[r+2],p0[r+3]);a=max3f(a,p1[r],p1[r+1]);b=max3f(b,p1[r+2],p1[r+3]);}
  const float m=max2f(a,b);
  auto rr=__builtin_amdgcn_permlane32_swap(__float_as_uint(m),__float_as_uint(m),false,false);
  return max2f(__uint_as_float(rr[0]),__uint_as_float(rr[1]));
}
__device__ __forceinline__ void pv(f32x16*o,int vb,bf16x8 pa0,bf16x8 pa1,bf16x8 pa2,bf16x8 pa3){
  #pragma unroll
  for(int d0=0;d0<2;++d0){s16x4 lo[4],hi[4];
    #pragma unroll
    for(int ks=0;ks<4;++ks){
      asm volatile("ds_read_b64_tr_b16 %0,%1 offset:%c2":"=&v"(lo[ks]):"v"(vb),"i"(d0*4096+ks*1024):"memory");
      asm volatile("ds_read_b64_tr_b16 %0,%1 offset:%c2":"=&v"(hi[ks]):"v"(vb),"i"(d0*4096+ks*1024+512):"memory");}
    asm volatile("s_waitcnt lgkmcnt(0)":::"memory");SBAR();
    #define PK(k) (bf16x8){lo[k][0],lo[k][1],lo[k][2],lo[k][3],hi[k][0],hi[k][1],hi[k][2],hi[k][3]}
    o[d0]=__builtin_amdgcn_mfma_f32_32x32x16_bf16(pa0,PK(0),o[d0],0,0,0);
    o[d0]=__builtin_amdgcn_mfma_f32_32x32x16_bf16(pa1,PK(1),o[d0],0,0,0);
    o[d0]=__builtin_amdgcn_mfma_f32_32x32x16_bf16(pa2,PK(2),o[d0],0,0,0);
    o[d0]=__builtin_amdgcn_mfma_f32_32x32x16_bf16(pa3,PK(3),o[d0],0,0,0);
    #undef PK
  }
}

#ifndef ATTN_STORE16
#define ATTN_STORE16(p,v) (*(u32x4*)(p)=(v))
#endif
__device__ __forceinline__ int t5_bucket(int d){ if(d<16)return d; const int large=16+(int)(__logf((float)d*(1.0f/16.0f))/2.0794415416798357f*16.0f); return large<31?large:31; }
template<int THRL> __device__ __forceinline__ void attn_unit(int b,int h,int qb,const bf16*Q,const bf16*__restrict__ K,const bf16*__restrict__ V,bf16*O,const float*kmean,const float*t5,char*shm){
  const int tid=threadIdx.x,lane=tid&63,r32=lane&31,hi=lane>>5; const int wid=__builtin_amdgcn_readfirstlane(tid>>6);
  const long rowbase=(long)b*SEQ; const int q0=qb*QB;
  const bf16*Qw=Q+(rowbase+q0+wid*QBLK)*DM+h*D;
  const bf16*Kh=K+rowbase*DM+h*D,*Vh=V+rowbase*DM+h*D;
  const unsigned lds0=(unsigned)(uintptr_t)shm;
  float*wsf=(float*)(shm+LDS_WS)+wid*64;
  const int qrel=wid*QBLK+r32;
  typedef __attribute__((address_space(3))) float lds_f32; typedef __attribute__((address_space(3))) unsigned lds_u32;
  lds_f32*TB=(lds_f32*)((__attribute__((address_space(3))) char*)shm+L_TB); lds_u32*SEL=(lds_u32*)((__attribute__((address_space(3))) char*)shm+L_SEL); lds_f32*KM=(lds_f32*)((__attribute__((address_space(3))) char*)shm+L_KM);
  asm volatile("":"+s"(TB),"+v"(SEL),"+v"(KM));
  int lo_=lane; asm volatile("":"+v"(lo_));
  const bf16*ksrc=Kh+(long)lo_*DM+wid*8;
  const bf16*vsrc=Vh+(long)(16*(wid&3)+(lo_>>2))*DM+(wid>>2)*32+(lo_&3)*8;
  const unsigned kdst=lds0+LDS_K+wid*1024, vdst=lds0+LDS_V+wid*1024;
  #define PHYS(t) ((t)<4?4*qb+(t):((t)<8?4*qb-8+(t):(t)-8))
  #define DMA_K(t,slot) glds16(ksrc+(long)PHYS(t)*KVBLK*DM,(unsigned)__builtin_amdgcn_readfirstlane(kdst+(slot)))
  #define DMA_V(t,slot) glds16(vsrc+(long)PHYS(t)*KVBLK*DM,(unsigned)__builtin_amdgcn_readfirstlane(vdst+(slot)))
  const int vb0=(int)(lds0+LDS_V)+((lane>>4)&1)*32+(lane&3)*8+(4*hi+((lane&15)>>2))*64;
  const char*Kbase=shm+LDS_K; bf16x8 kf[8];
  const lds_cptr shm3=(lds_cptr)shm; const lds_cptr kp0=shm3+LDS_K+hi*1024+r32*16; const lds_cptr vp0=shm3+LDS_V+((lane>>4)&1)*32+(lane&3)*8+(4*hi+((lane&15)>>2))*64;
  const int NT=4*(qb+1);
  DMA_K(0,0);DMA_V(0,0);DMA_K(1,SLOTB);
  bf16x8 qr[4];
  #pragma unroll
  for(int d0=0;d0<4;++d0)qr[d0]=*reinterpret_cast<const bf16x8*>(&Qw[(long)r32*DM+d0*16+hi*8]);
  DMA_K(2,2*SLOTB);
  { int tt=tid; asm volatile("":"+v"(tt));
    { const int d_=tt-128; TB[tt]=d_<0?NEGBIG:t5[t5_bucket(d_<128?d_:128)*8+h]*LOG2E; } }
  for(int idx=tid;idx<1024;idx+=512)KM[(idx>>6)*68+(idx&63)]=(idx<qb*64)?kmean[((size_t)(b*16+(idx>>6))*8+h)*64+(idx&63)]:0.f;
  asm volatile("s_waitcnt vmcnt(0) lgkmcnt(0)\n\ts_barrier":::"memory");
  unsigned selm=0u;
  { f32x16 gacc=f32x16{};
    _Pragma("unroll") for(int d0=0;d0<4;++d0){ float kmv[8];
      { const f32x4_t ka=*(const __attribute__((address_space(3))) f32x4_t*)(KM+(r32&15)*68+16*d0+8*hi), kb=*(const __attribute__((address_space(3))) f32x4_t*)(KM+(r32&15)*68+16*d0+8*hi+4);
        _Pragma("unroll") for(int e=0;e<4;++e){ kmv[e]=r32<16?ka[e]:0.f; kmv[4+e]=r32<16?kb[e]:0.f; } }
      u32x4 wh,wl; float rs[8];
      wh[0]=cvtpk_s(kmv[0],kmv[1]);wh[1]=cvtpk_s(kmv[2],kmv[3]);wh[2]=cvtpk_s(kmv[4],kmv[5]);wh[3]=cvtpk_s(kmv[6],kmv[7]);
      _Pragma("unroll") for(int e=0;e<4;++e){ rs[2*e]=kmv[2*e]-__uint_as_float(wh[e]<<16); rs[2*e+1]=kmv[2*e+1]-__uint_as_float(wh[e]&0xffff0000u); }
      wl[0]=cvtpk_s(rs[0],rs[1]);wl[1]=cvtpk_s(rs[2],rs[3]);wl[2]=cvtpk_s(rs[4],rs[5]);wl[3]=cvtpk_s(rs[6],rs[7]);
      gacc=__builtin_amdgcn_mfma_f32_32x32x16_bf16(__builtin_bit_cast(bf16x8,wh),qr[d0],gacc,0,0,0);
      gacc=__builtin_amdgcn_mfma_f32_32x32x16_bf16(__builtin_bit_cast(bf16x8,wl),qr[d0],gacc,0,0,0); }
    float G[16];
    _Pragma("unroll") for(int r=0;r<8;++r){ auto rr=__builtin_amdgcn_permlane32_swap(__float_as_uint(gacc[r]),__float_as_uint(gacc[r]),false,false); G[(r&3)+8*(r>>2)]=__uint_as_float(rr[0]); G[(r&3)+8*(r>>2)+4]=__uint_as_float(rr[1]); }
    float v1=-INFINITY,v2=-INFINITY,v3=-INFINITY; int i1=-1,i2=-1,i3=-1;
    _Pragma("unroll") for(int j=0;j<15;++j) if(j<qb){ const float x=G[j];
      if(x>v1){v3=v2;i3=i2;v2=v1;i2=i1;v1=x;i1=j;} else if(x>v2){v3=v2;i3=i2;v2=x;i2=j;} else if(x>v3){v3=x;i3=j;} }
    selm=(i1>=0?1u<<i1:0u)|(i2>=0?1u<<i2:0u)|(i3>=0?1u<<i3:0u); }
  const float tb128=__builtin_bit_cast(float,__builtin_amdgcn_readfirstlane(__builtin_bit_cast(int,(float)TB[256])));
  float mhat=0.f,l_reg=0.f;f32x16 o[2];o[0]=f32x16{};o[1]=f32x16{};f32x16 negm=f32x16{};asm volatile("":"+v"(negm));
  #define PRE(P0,P1,t) do{ const float base_=addend-mhat; int qv_=qrel-4*hi; asm volatile("":"+v"(qv_));   \
      const int jb_=(t)&3; \
      if((t)<4&&64*jb_>32*wid+31){ _Pragma("unroll") for(int r=0;r<16;++r){ P0[r]=NEGBIG; P1[r]=NEGBIG; } }                                    \
      else if((t)<4&&32*wid-64*jb_-63<128){ const lds_f32*a_=TB+(69+qv_-64*jb_);   \
        _Pragma("unroll") for(int r=0;r<16;++r){ P0[r]=a_[59-((r&3)+8*(r>>2))]+base_; P1[r]=a_[27-((r&3)+8*(r>>2))]+base_; } } \
      else if((t)>=4&&(t)<8&&32*wid+65<64*jb_){ const lds_f32*a_=TB+(69+256+qv_-64*jb_); \
        _Pragma("unroll") for(int r=0;r<16;++r){ P0[r]=a_[59-((r&3)+8*(r>>2))]+base_; P1[r]=a_[27-((r&3)+8*(r>>2))]+base_; } } \
      else { const float bb_=(t)<8?base_+tb128:base_; _Pragma("unroll") for(int r=0;r<16;++r){ P0[r]=bb_; P1[r]=bb_; } }                         \
      asm volatile("":"+v"(P0),"+v"(P1)); }while(0)
  #define CMASK(P0,P1,t) do{}while(0)
  float addend=0.f;
  #define UPD(t) do{ if(((t)&3)==0&&(t)>=4){ const int blk_=(t)<8?qb-1:(((t)-8)>>2); const bool s_=(selm>>blk_)&1u; addend=s_?((t)<8?0.f:tb128):NEGBIG; \
      _Pragma("unroll") for(int r=0;r<16;++r)negm[r]=addend-mhat; asm volatile("":"+v"(negm)); } }while(0)
  bool resc=false;
  #define START(P0,P1) do{ const float rm=rowmax(P0,P1); resc=false; \
    { const float dl=rm; mhat=fadd_s(mhat,dl); \
      _Pragma("unroll") for(int r=0;r<16;++r){P0[r]=fsub_s(P0[r],dl);P1[r]=fsub_s(P1[r],dl);} \
      _Pragma("unroll") for(int r=0;r<16;++r)negm[r]=addend-mhat; asm volatile("":"+v"(negm)); } \
    _Pragma("unroll") for(int r=0;r<16;++r)P0[r]=__builtin_amdgcn_exp2f(P0[r]); }while(0)
  #define RESC() do{ if(resc){ asm volatile("s_waitcnt lgkmcnt(0)":::"memory"); \
      _Pragma("unroll") for(int d_=0;d_<2;++d_) _Pragma("unroll") for(int r=0;r<16;++r)o[d_][r]*=wsf[crow(r,hi)]; } }while(0)
  f32x16 pA0,pA1,pB0,pB1;
  int sl_prev=0,sl_cur=0,sl_next=SLOTB;
  #define ROT() do{sl_prev=sl_cur;sl_cur=sl_next;sl_next=(sl_next==(NSLOT-1)*SLOTB)?0:sl_next+SLOTB;}while(0)
  PRE(pA0,pA1,0); qkt(pA0,pA1,Kbase,qr,r32,hi);asm volatile("s_nop 15\n\ts_nop 7":"+v"(pA0),"+v"(pA1));
  START(pA0,pA1);
  _Pragma("unroll") for(int r=0;r<16;++r)pA1[r]=__builtin_amdgcn_exp2f(pA1[r]);
  WAIT_BAR(0);
  DMA_K(3,0);DMA_V(1,SLOTB);
  ROT();
  kload8(kf,kp0+sl_cur);
  WAIT_BAR(2);
  s16x4 vlo[8],vhi[8]; u32x4 pw0,pw1,pw2,pw3;
  #define PKW(P,B) cvtpk_s(P[B],P[B+1])
  #define PAF(k) __builtin_bit_cast(bf16x8,pw##k)
  #define VFR(i) (bf16x8){vlo[i][0],vlo[i][1],vlo[i][2],vlo[i][3],vhi[i][0],vhi[i][1],vhi[i][2],vhi[i][3]}
  #define PIN(x) asm volatile("":"+v"(x))
  #define MX3(a,b,c) __builtin_fmaxf(__builtin_fmaxf((a),(b)),(c))
  #define GAPA(MF,A0,A1,A2,A3,W0,W1,PW) do{ MF; sacc+=A0; sacc+=A1; sacc+=A2; sacc+=A3; PIN(sacc); W0; W1; PIN(PW); SBAR(); }while(0)
  #define EX(v) __builtin_amdgcn_exp2f(v)
  #define GAPB(MF,X,B) do{ MF; X[B]=EX(X[B]); X[B+1]=EX(X[B+1]); X[B+2]=EX(X[B+2]); X[B+3]=EX(X[B+3]); PIN(X); SBAR(); }while(0)
  #define VRD(i) do{ vlo[i]=vtr(vp_+(((i)>>2)*4096+((i)&3)*1024)); vhi[i]=vtr(vp_+(((i)>>2)*4096+((i)&3)*1024+512)); }while(0)
  #define KRD(G,j) do{ if(G){ kload2(kf,kp0+sl_next,j); SBAR(); } }while(0)
  #define STEP(C0,C1,P0,P1,t,GK,GV,GL,CI0,CI1) do{ SBAR(); \
    const lds_cptr vp_=vp0+sl_prev; \
    VRD(0); SBAR(); float sacc=(P0[0]+P0[1]); \
    GAPA(C0=__builtin_amdgcn_mfma_f32_32x32x16_bf16(kf[0],qr[0],CI0,0,0,0), P0[2],P0[3],P0[4],P0[5],     pw0[0]=PKW(P0,0), pw0[1]=PKW(P0,2), pw0); \
    VRD(4); SBAR(); GAPA(C1=__builtin_amdgcn_mfma_f32_32x32x16_bf16(kf[1],qr[0],CI1,0,0,0), P0[6],P0[7],P0[8],P0[9],     pw0[2]=PKW(P0,4), pw0[3]=PKW(P0,6), pw0); \
    VRD(1); SBAR(); GAPA(C0=__builtin_amdgcn_mfma_f32_32x32x16_bf16(kf[2],qr[1],C0,0,0,0),   P0[10],P0[11],P0[12],P0[13], pw1[0]=PKW(P0,8), pw1[1]=PKW(P0,10), pw1); \
    VRD(5); SBAR(); GAPA(C1=__builtin_amdgcn_mfma_f32_32x32x16_bf16(kf[3],qr[1],C1,0,0,0),   P0[14],P0[15],P1[0],P1[1],   pw1[2]=PKW(P0,12),pw1[3]=PKW(P0,14), pw1); \
    VRD(2); SBAR(); GAPA(C0=__builtin_amdgcn_mfma_f32_32x32x16_bf16(kf[4],qr[2],C0,0,0,0),   P1[2],P1[3],P1[4],P1[5],     pw2[0]=PKW(P1,0), pw2[1]=PKW(P1,2), pw2); \
    VRD(6); SBAR(); GAPA(C1=__builtin_amdgcn_mfma_f32_32x32x16_bf16(kf[5],qr[2],C1,0,0,0),   P1[6],P1[7],P1[8],P1[9],     pw2[2]=PKW(P1,4), pw2[3]=PKW(P1,6), pw2); \
    VRD(3); SBAR(); GAPA(C0=__builtin_amdgcn_mfma_f32_32x32x16_bf16(kf[6],qr[3],C0,0,0,0),   P1[10],P1[11],P1[12],P1[13], pw3[0]=PKW(P1,8), pw3[1]=PKW(P1,10), pw3); \
    VRD(7); SBAR(); GAPA(C1=__builtin_amdgcn_mfma_f32_32x32x16_bf16(kf[7],qr[3],C1,0,0,0),   P1[14],P1[15],0.f,0.f,       pw3[2]=PKW(P1,12),pw3[3]=PKW(P1,14), pw3); \
    l_reg+=sacc; \
    if(GK){DMA_K((t)+3,sl_cur);} if(GV){DMA_V((t)+1,sl_next);} \
    CMASK(C0,C1,t); \
    { float a=MX3(C0[0],C0[1],C1[0]),b=MX3(C0[2],C0[3],C1[1]); a=MX3(a,C1[2],C1[3]); \
      _Pragma("unroll") for(int r=4;r<16;r+=4){a=MX3(a,C0[r],C0[r+1]);b=MX3(b,C0[r+2],C0[r+3]);a=MX3(a,C1[r],C1[r+1]);b=MX3(b,C1[r+2],C1[r+3]);} \
      float rm=__builtin_fmaxf(a,b); { auto rr=__builtin_amdgcn_permlane32_swap(__float_as_uint(rm),__float_as_uint(rm),false,false); rm=__builtin_fmaxf(__uint_as_float(rr[0]),__uint_as_float(rr[1])); } \
      resc=false; \
      if(__builtin_expect(__any(rm>(float)THRL),0)){ const float dl=__builtin_fmaxf(rm,0.f); mhat+=dl; \
        _Pragma("unroll") for(int r=0;r<16;++r){C0[r]-=dl;C1[r]-=dl;} \
        _Pragma("unroll") for(int r=0;r<16;++r)negm[r]=addend-mhat; asm volatile("":"+v"(negm)); \
        const float f=__builtin_amdgcn_exp2f(-dl); l_reg*=f; if(hi==0)wsf[r32]=f; resc=true; } } \
    SBAR(); \
    GAPB(o[0]=__builtin_amdgcn_mfma_f32_32x32x16_bf16(PAF(0),VFR(0),o[0],0,0,0), C0,0); \
    GAPB(o[1]=__builtin_amdgcn_mfma_f32_32x32x16_bf16(PAF(0),VFR(4),o[1],0,0,0), C0,4); \
    KRD(GL,0); GAPB(o[0]=__builtin_amdgcn_mfma_f32_32x32x16_bf16(PAF(1),VFR(1),o[0],0,0,0), C0,8); \
    KRD(GL,1); GAPB(o[1]=__builtin_amdgcn_mfma_f32_32x32x16_bf16(PAF(1),VFR(5),o[1],0,0,0), C0,12); \
    KRD(GL,2); GAPB(o[0]=__builtin_amdgcn_mfma_f32_32x32x16_bf16(PAF(2),VFR(2),o[0],0,0,0), C1,0); \
    KRD(GL,3); GAPB(o[1]=__builtin_amdgcn_mfma_f32_32x32x16_bf16(PAF(2),VFR(6),o[1],0,0,0), C1,4); \
    GAPB(o[0]=__builtin_amdgcn_mfma_f32_32x32x16_bf16(PAF(3),VFR(3),o[0],0,0,0), C1,8); \
    GAPB(o[1]=__builtin_amdgcn_mfma_f32_32x32x16_bf16(PAF(3),VFR(7),o[1],0,0,0), C1,12); \
    }while(0)
  int t=1;
  #define ENDW(tt) do{ if((tt)+3<NT){WAIT_BAR(2);} else if((tt)+2<NT){WAIT_BAR(1);} else {WAIT_BAR(0);} }while(0)
  for(;t+1<NT&&t<9;t+=2){
    UPD(t);   PRE(pB0,pB1,t);   STEP(pB0,pB1,pA0,pA1,t,(t+3<NT),(t+1<NT),(t+1<NT),pB0,pB1);       ENDW(t);   RESC(); ROT();
    UPD(t+1); PRE(pA0,pA1,t+1); STEP(pA0,pA1,pB0,pB1,t+1,(t+4<NT),(t+2<NT),(t+2<NT),pA0,pA1);     ENDW(t+1); RESC(); ROT();
  }
  for(;t+5<NT;t+=2){
    UPD(t);   STEP(pB0,pB1,pA0,pA1,t,true,true,true,negm,negm);     WAIT_BAR(2); RESC(); ROT();
    UPD(t+1); STEP(pA0,pA1,pB0,pB1,t+1,true,true,true,negm,negm);   WAIT_BAR(2); RESC(); ROT();
  }
  for(;t+1<NT;t+=2){
    UPD(t);   PRE(pB0,pB1,t);   STEP(pB0,pB1,pA0,pA1,t,(t+3<NT),(t+1<NT),(t+1<NT),pB0,pB1);       ENDW(t);   RESC(); ROT();
    UPD(t+1); PRE(pA0,pA1,t+1); STEP(pA0,pA1,pB0,pB1,t+1,(t+4<NT),(t+2<NT),(t+2<NT),pA0,pA1);     ENDW(t+1); RESC(); ROT();
  }
  UPD(NT-1); PRE(pB0,pB1,NT-1);
  STEP(pB0,pB1,pA0,pA1,NT-1,false,false,false,pB0,pB1); RESC();
  { float sacc=pB0[0]+pB0[1]; _Pragma("unroll") for(int r=2;r<16;++r)sacc+=pB0[r]; _Pragma("unroll") for(int r=0;r<16;++r)sacc+=pB1[r]; l_reg+=sacc;
    pw0=(u32x4){PKW(pB0,0),PKW(pB0,2),PKW(pB0,4),PKW(pB0,6)};pw1=(u32x4){PKW(pB0,8),PKW(pB0,10),PKW(pB0,12),PKW(pB0,14)};pw2=(u32x4){PKW(pB1,0),PKW(pB1,2),PKW(pB1,4),PKW(pB1,6)};pw3=(u32x4){PKW(pB1,8),PKW(pB1,10),PKW(pB1,12),PKW(pB1,14)};
    SBAR(); pv(o,vb0+sl_cur,PAF(0),PAF(1),PAF(2),PAF(3)); }
  #undef PKW
  #undef PAF
  #undef VFR
  #undef PIN
  #undef MX3
  #undef GAPA
  #undef GAPB
  #undef EX
  #undef VRD
  #undef KRD
  #undef STEP
  #undef ENDW
  {auto rr=__builtin_amdgcn_permlane32_swap(__float_as_uint(l_reg),__float_as_uint(l_reg),false,false);l_reg=__uint_as_float(rr[0])+__uint_as_float(rr[1]);}
  if(hi==0)wsf[32+r32]=l_reg;asm volatile("s_waitcnt lgkmcnt(0)":::"memory");
  float rli[16];
  #pragma unroll
  for(int r=0;r<16;++r)rli[r]=__builtin_amdgcn_rcpf(wsf[32+crow(r,hi)]);
  bf16*Ow=O+(rowbase+q0+wid*QBLK)*DM+h*D;
  { bf16*stg=(bf16*)(shm+LDS_OST)+wid*2048;
    #pragma unroll
    for(int r=0;r<16;++r){const int orow=crow(r,hi);
      #pragma unroll
      for(int d0=0;d0<2;++d0)stg[orow*64+d0*32+r32]=(bf16)f2bf_(o[d0][r]*rli[r]);}
    asm volatile("s_waitcnt lgkmcnt(0)":::"memory");
    #pragma unroll
    for(int i=0;i<4;++i){const int row=i*8+(lane>>3),ch=lane&7; const u32x4 v=*(const u32x4*)(stg+row*64+ch*8); ATTN_STORE16(Ow+(long)row*DM+ch*8,v);} }
  asm volatile("s_waitcnt lgkmcnt(0)\n\ts_barrier":::"memory");
  #undef PHYS
  #undef PRE
  #undef UPD
  #undef DMA_K
  #undef DMA_V
  #undef CMASK
  #undef START
  #undef RESC
  #undef ROT
}
#undef SBAR
#undef WAIT_BAR
}
#ifndef SKIP_MOBA
#define SKIP_MOBA 0
#endif
struct Args { const float* in[15]; float* out; unsigned char* ws; int ph_lo, ph_hi; };
#define CAS __attribute__((address_space(4)))
__global__ void __launch_bounds__(NWAVES * 64, 2) hybrid_fwd(Args args) {
    extern __shared__ __attribute__((aligned(16))) unsigned char lds[];
    Frame F;
    F.lds = (LAS unsigned char*)lds;
    F.MISC = (volatile LAS unsigned*)(F.lds + MISC_OFF);
    F.tid = threadIdx.x; F.lane = F.tid & 63; F.wave = __builtin_amdgcn_readfirstlane(F.tid >> 6);
    F.G = gridDim.x; { const int bx = blockIdx.x; F.vcu = (F.G % 8 == 0) ? (bx % 8) * (F.G / 8) + bx / 8 : bx; }
    { const CAS Args* ap0 = (const CAS Args*)__builtin_amdgcn_kernarg_segment_ptr(); F.ctl = (gu32*)(ap0->ws + WS_CTL); }
#define PHASE_ARGS() const CAS Args* ap_ = (const CAS Args*)__builtin_amdgcn_kernarg_segment_ptr(); asm volatile("" : "+s"(ap_)); unsigned char* ws = ap_->ws; Ptrs P; \
    P.x = ap_->in[0]; P.g1 = ap_->in[1]; P.w_in = ap_->in[2]; P.qg = ap_->in[3]; P.kg = ap_->in[4]; P.t5 = ap_->in[5]; P.gup = ap_->in[6]; P.gbias = ap_->in[7]; \
    P.gnorm = ap_->in[8]; P.wba = ap_->in[9]; P.wbg = ap_->in[10]; P.wout = ap_->in[11]; P.g2 = ap_->in[12]; P.wup = ap_->in[13]; P.wdn = ap_->in[14]; P.out = ap_->out; P.ws = ws; \
    bf16* XN = (bf16*)(ws + WS_XN); bf16* H1B = (bf16*)(ws + WS_H1B); bf16* HB = (bf16*)(ws + WS_HB); float* SSQ = (float*)(ws + WS_SSQ); \
    bf16* QB_ = (bf16*)(ws + WS_Q); bf16* KB_ = (bf16*)(ws + WS_K); bf16* VB_ = (bf16*)(ws + WS_V); bf16* GO_ = (bf16*)(ws + WS_GO); bf16* MIX = (bf16*)(ws + WS_MIX); \
    bf16* SA = (bf16*)P.out; bf16* SG = (bf16*)P.out + (size_t)M * 1024; float* KMEAN = (float*)(ws + WS_KMEAN); \
    (void)XN; (void)H1B; (void)HB; (void)SSQ; (void)QB_; (void)KB_; (void)VB_; (void)GO_; (void)MIX; (void)SA; (void)SG; (void)KMEAN;
    for (int u = F.tid; u < (LDS_BYTES - LDSCTL_OFF) / 4; u += NWAVES * 64) ((LAS unsigned*)(F.lds + LDSCTL_OFF))[u] = 0u;
    __syncthreads();
    XcdBarrier bar; bar.bar = (unsigned*)(F.ctl + CW_BAR); bar.x = 0; bar.st = nullptr;
    if (N_LAUNCHES == 1) bar = xcd_barrier_post((unsigned*)(F.ctl + CW_BAR), F.MISC + 8);
#define GRID_BAR() do { if (N_LAUNCHES == 1) xcd_barrier(bar); } while (0)
    const int lo = args.ph_lo, hi = args.ph_hi;
#define IN(k) (lo <= (k) && (k) < hi)
#define BOTH(k) (IN(k) && IN((k) + 1))
    if (IN(0)) { PHASE_ARGS(); p0_prologue(F, P); if (BOTH(0)) GRID_BAR(); }
    if (IN(1)) { PHASE_ARGS();
        pg8::Gemm g{XN, (const bf16*)(ws + WS_WIN), M, NPROJ, DMODEL}; pg8::StaticOrder S; S.init(M, NPROJ, F.G, (int)blockIdx.x);
        {
        pg8::EpiProj E{QB_, KB_, VB_, (bf16*)(ws + WS_GV), SA, KMEAN, P.qg, P.kg};
        static_assert(WS_GQ == WS_V + 32 * MiB && WS_GK == WS_V + 64 * MiB && WS_GO == WS_GV + 64 * MiB, "EpiProj strides");
        pg8::gemm_phase<pg8::EpiProj, pg8::StaticOrder, true, true>(F.lds + RING_OFF, g, S, E); }
        p1_glow(F, P);
        if (BOTH(1)) GRID_BAR();
    }
    if (IN(2)) { PHASE_ARGS(); if (F.G == 256) for (int i = 0; i < 2; ++i) { const int U = F.vcu * 2 + i; gla_prep_unit(F, P, U >> 6, U & 63); } if (BOTH(2)) GRID_BAR(); }
    if (IN(3)) {
        if (F.G == 256 && (F.vcu & 2) == 0) { PHASE_ARGS(); gla_fused64(F, P, 2 * (F.vcu >> 2) + (F.vcu & 1)); }
        { int t_ = threadIdx.x; asm volatile("" : "+v"(t_)); F.tid = t_; F.lane = t_ & 63; }
        PHASE_ARGS();
        if (F.G == 256) {
            const int bh = F.vcu >> 2, s = F.vcu & 3;
            const unsigned packed = s == 0 ? 0x1Fu : s == 2 ? 0x0678ADu : s == 1 ? 0x2Eu : 0x3459BCu; const int cnt = (s & 2) ? 6 : 2;
            for (int i = 0; i < cnt; ++i) { const int qb = (packed >> (4 * i)) & 15;
                moba::attn_unit<8>(bh >> 3, bh & 7, qb, QB_, KB_, VB_, QB_, KMEAN, P.t5, (char*)lds + RING_OFF); }
        }
        { PHASE_ARGS(); p1_late_weights(F, P); }
        if (BOTH(3)) GRID_BAR();
    }
    if (IN(4)) { PHASE_ARGS();
        { pg8::Gemm g{QB_, (const bf16*)(ws + WS_WBA), M, DMODEL, 512}; pg8::StaticOrder S; S.init(M, DMODEL, F.G, (int)blockIdx.x);
          pg8::EpiMix<false> E{SA, MIX, nullptr};
          pg8::gemm_phase<pg8::EpiMix<false>, pg8::StaticOrder, true, true>(F.lds + RING_OFF, g, S, E); }
        { pg8::Gemm g{GO_, (const bf16*)(ws + WS_WBG), M, DMODEL, DMODEL}; pg8::StaticOrder S; S.init(M, DMODEL, F.G, (int)blockIdx.x);
          pg8::EpiMix<true> E{SG, MIX, (const float*)(ws + WS_SSQ2)};
          pg8::gemm_phase<pg8::EpiMix<true>, pg8::StaticOrder, true, true>(F.lds + RING_OFF, g, S, E); }
        if (BOTH(4)) GRID_BAR();
    }
    if (IN(5)) { PHASE_ARGS();
        pg8::Gemm g{MIX, (const bf16*)(ws + WS_WOUT), M, DMODEL, DMODEL}; pg8::StaticOrder S; S.init(M, DMODEL, F.G, (int)blockIdx.x);
        pg8::EpiWout E{P.x, P.out, H1B, SSQ};
        pg8::gemm_phase<pg8::EpiWout, pg8::StaticOrder, true, true>(F.lds + RING_OFF, g, S, E);
        if (BOTH(5)) GRID_BAR();
    }
    if (IN(6)) { PHASE_ARGS();
        pg8::Gemm g{H1B, (const bf16*)(ws + WS_WUP), M, FF, DMODEL}; pg8::StaticOrder S; S.init(M, FF, F.G, (int)blockIdx.x);
        pg8::EpiUp E{SSQ, HB};
        pg8::gemm_phase<pg8::EpiUp, pg8::StaticOrder, true, true>(F.lds + RING_OFF, g, S, E);
        if (BOTH(6)) GRID_BAR();
    }
    if (IN(7)) { PHASE_ARGS();
        pg8::Gemm g{HB, (const bf16*)(ws + WS_WDN), M, DMODEL, FF}; pg8::StaticOrderRev S; S.init(M, DMODEL, F.G, (int)blockIdx.x);
        pg8::EpiDown E{H1B, P.out};
        pg8::gemm_phase<pg8::EpiDown, pg8::StaticOrderRev, true, true>(F.lds + RING_OFF, g, S, E);
    }
#undef IN
#undef BOTH
}
extern "C" void kernel_launch(void* const* d_in, const int* in_sizes, int n_in, void* d_out, int out_size, void* d_ws, size_t ws_size, hipStream_t stream) {
    static int grid = 0;
    if (grid == 0) {
        if (n_in != 15 || in_sizes[0] != M * DMODEL || out_size != M * DMODEL || ws_size < WS_END) { fprintf(stderr, "kernel_launch: unexpected shapes/workspace (n_in %d, in0 %d, out %d, ws %zu)\n", n_in, n_in > 0 ? in_sizes[0] : -1, out_size, ws_size); grid = -1; return; }
        int dev = 0, cus = 0, per_cu = 0;
        if (hipGetDevice(&dev) != hipSuccess || hipDeviceGetAttribute(&cus, hipDeviceAttributeMultiprocessorCount, dev) != hipSuccess) { grid = -1; return; }
        if (hipFuncSetAttribute((const void*)hybrid_fwd, hipFuncAttributeMaxDynamicSharedMemorySize, LDS_BYTES) != hipSuccess) { fprintf(stderr, "kernel_launch: hipFuncSetAttribute failed\n"); grid = -1; return; }
        if (hipOccupancyMaxActiveBlocksPerMultiprocessor(&per_cu, (const void*)hybrid_fwd, NWAVES * 64, LDS_BYTES) != hipSuccess || per_cu < 1)
            fprintf(stderr, "kernel_launch: note: occupancy query reports %d workgroups per CU\n", per_cu);
        (void)hipGetLastError();
        grid = cus;
        if (grid != 256) fprintf(stderr, "kernel_launch: %d CUs (built for 256)\n", grid);
    }
    if (grid < 0) return;
    if (hipMemsetAsync((char*)d_ws + WS_CTL, 0, CTL_ZERO_BYTES, stream) != hipSuccess) { fprintf(stderr, "kernel_launch: hipMemsetAsync failed\n"); return; }
    Args a{};
    for (int i = 0; i < 15; ++i) a.in[i] = (const float*)d_in[i];
    a.out = (float*)d_out; a.ws = (unsigned char*)d_ws;
    for (int li = 0; li < N_LAUNCHES; ++li) {
        a.ph_lo = (N_LAUNCHES == 1) ? 0 : li; a.ph_hi = (N_LAUNCHES == 1) ? N_PHASES : li + 1;
        hipLaunchKernelGGL(hybrid_fwd, dim3(grid), dim3(NWAVES * 64), LDS_BYTES, stream, a);
        const hipError_t le = hipPeekAtLastError();
        if (le != hipSuccess) { fprintf(stderr, "kernel_launch: launch %d failed: %s\n", li, hipGetErrorName(le)); break; }
    }
}
```
